# Optimizing an MI355X kernel written in HIP

```python
import math
import jax, jax.numpy as jnp
from jax import lax
import numpy as np

D_MODEL = 1024
BATCH = 32
SEQ = 256
DEPTH = 2
DEC_BATCH = 4
DEC_SEQ = 2048
PAST_LEN = 512

GRID_W = 64
FF_HIDDEN = 2816
N_MOD = 9
HEAD_DIM = 64
FN_WIDTH = D_MODEL // 4
FN_GROUP_DIM = HEAD_DIM
FN_GROUPS = FN_WIDTH // FN_GROUP_DIM
SSD_INNER = 3 * D_MODEL // 8
SSD_HEAD_DIM = HEAD_DIM
SSD_HEADS = SSD_INNER // SSD_HEAD_DIM
SSD_STATE = 64
SSD_NGROUPS = 2
SSD_CONV = 5
SSD_CHUNK = 128
SSD_CONV_DIM = SSD_INNER + 2 * SSD_NGROUPS * SSD_STATE
SSD_IN = SSD_INNER + SSD_CONV_DIM + 2 * SSD_HEADS
NA_WIDTH = 3 * D_MODEL // 8
NA_HEAD_DIM = HEAD_DIM
NA_HEADS = NA_WIDTH // NA_HEAD_DIM
NA_WIN_ROWS = 8
NA_WIN_COLS = 16
Q_BLOCK = 128
MIX_WIDTH = FN_WIDTH + SSD_INNER + NA_WIDTH
IN_COLS = FN_WIDTH + SSD_IN + 3 * NA_WIDTH
ROPE_BASE = 10000.0
EPS = 1e-6

kernel_name = "hybrid_fourier_ssd_natten_prefix_diffusion_step"


def rmsnorm(x, g):
    xf = x.astype(jnp.float32)
    y = xf * lax.rsqrt(jnp.mean(xf * xf, axis=-1, keepdims=True) + EPS)
    return (y * g.astype(jnp.float32)).astype(x.dtype)


def modulated_norm(x, g, shift, scale):
    return rmsnorm(x, g) * (1 + scale) + shift


def swiglu(h, w13, w2):
    gate, up = jnp.split(h @ w13, 2, axis=-1)
    return (jax.nn.silu(gate) * up) @ w2


def half_ffn(x, shift, scale, gate, g_pre, g_post, w13, w2):
    h = modulated_norm(x, g_pre, shift, scale)
    return x + 0.5 * gate * rmsnorm(swiglu(h, w13, w2), g_post)


def fourier_mix(u):
    b, L, _ = u.shape
    uf = u.astype(jnp.float32).reshape(b, L, FN_GROUPS, FN_GROUP_DIM)
    y = jnp.fft.fftn(uf, axes=(1, 3), norm="ortho").real
    return y.reshape(b, L, FN_WIDTH).astype(u.dtype)


def centred_depthwise_conv(x, w, bias):
    ch = x.shape[-1]
    y = lax.conv_general_dilated(x, w.astype(x.dtype)[:, None, :], window_strides=(1,),
                                 padding=[(SSD_CONV // 2, SSD_CONV // 2)],
                                 dimension_numbers=("NWC", "WIO", "NWC"),
                                 feature_group_count=ch)
    return y + bias.astype(x.dtype)


def axial_rope(x):
    L, n = x.shape[1], x.shape[-1]
    half = n // 2
    quarter = half // 2
    inv = ROPE_BASE ** (-jnp.arange(quarter, dtype=jnp.float32) / quarter)
    t = jnp.arange(L)
    rows = (t // GRID_W).astype(jnp.float32)
    cols = (t % GRID_W).astype(jnp.float32)

    def rot(v, pos):
        ang = pos[:, None] * inv[None, :]
        cos = jnp.cos(ang)[None, :, None, :]
        sin = jnp.sin(ang)[None, :, None, :]
        v1, v2 = v[..., :quarter], v[..., quarter:]
        return jnp.concatenate([v1 * cos - v2 * sin, v1 * sin + v2 * cos], axis=-1)

    xf = x.astype(jnp.float32)
    return jnp.concatenate([rot(xf[..., :half], rows), rot(xf[..., half:], cols)], axis=-1).astype(x.dtype)


def ssd_scan(x, dt, a, b_mat, c_mat, init):
    bsz, L, H, P = x.shape
    nc = L // SSD_CHUNK

    def chunk(t):
        return t.reshape((bsz, nc, SSD_CHUNK) + t.shape[2:])

    xdt = chunk(x * dt[..., None])
    cs = jnp.cumsum(chunk(dt * a), axis=2)
    bc, cc = chunk(b_mat), chunk(c_mat)
    lower = jnp.tril(jnp.ones((SSD_CHUNK, SSD_CHUNK), dtype=bool))
    seg = cs[:, :, :, None, :] - cs[:, :, None, :, :]
    decay = jnp.exp(jnp.where(lower[None, None, :, :, None], seg, -jnp.inf))
    scores = jnp.einsum("bclhn,bcshn->bclsh", cc, bc) * decay
    y_diag = jnp.einsum("bclsh,bcshp->bclhp", scores, xdt)
    decay_to_end = jnp.exp(cs[:, :, -1:, :] - cs)
    states = jnp.einsum("bclhn,bclh,bclhp->bchpn", bc, decay_to_end, xdt)
    chunk_decay = jnp.exp(cs[:, :, -1, :])

    def step(s, inp):
        st, dec = inp
        return s * dec[:, :, None, None] + st, s

    final, prev = lax.scan(step, init, (jnp.moveaxis(states, 1, 0), jnp.moveaxis(chunk_decay, 1, 0)))
    prev = jnp.moveaxis(prev, 0, 1)
    y_off = jnp.einsum("bclhn,bchpn,bclh->bclhp", cc, prev, jnp.exp(cs))
    return (y_diag + y_off).reshape(bsz, L, H, P), final


def ssd_mixer(u, p, init_f, init_b, use_rope):
    b, L, _ = u.shape
    z = u[..., :SSD_INNER]
    xbc = jax.nn.silu(centred_depthwise_conv(u[..., SSD_INNER:SSD_INNER + SSD_CONV_DIM], p["conv_w"], p["conv_b"]))
    dt_raw = u[..., SSD_INNER + SSD_CONV_DIM:]
    gn = SSD_NGROUPS * SSD_STATE
    xs = xbc[..., :SSD_INNER].astype(jnp.float32).reshape(b, L, SSD_HEADS, SSD_HEAD_DIM)
    bm = xbc[..., SSD_INNER:SSD_INNER + gn].reshape(b, L, SSD_NGROUPS, SSD_STATE)
    cm = xbc[..., SSD_INNER + gn:].reshape(b, L, SSD_NGROUPS, SSD_STATE)
    if use_rope:
        bm, cm = axial_rope(bm), axial_rope(cm)
    rep = SSD_HEADS // SSD_NGROUPS
    bh = jnp.repeat(bm.astype(jnp.float32), rep, axis=2)
    ch = jnp.repeat(cm.astype(jnp.float32), rep, axis=2)
    dt = jax.nn.softplus(dt_raw.astype(jnp.float32).reshape(b, L, 2, SSD_HEADS)
                         + p["dt_bias"].astype(jnp.float32))
    a = -jnp.exp(p["a_log"].astype(jnp.float32))
    y_f, s_f = ssd_scan(xs, dt[:, :, 0], a[0], bh, ch, init_f.astype(jnp.float32))
    fl = lambda t: jnp.flip(t, axis=1)
    y_b, s_b = ssd_scan(fl(xs), fl(dt[:, :, 1]), a[1], fl(bh), fl(ch), init_b.astype(jnp.float32))
    y = y_f + fl(y_b) + xs * p["d"].astype(jnp.float32)[:, None]
    y = y.reshape(b, L, SSD_INNER) * jax.nn.silu(z.astype(jnp.float32))
    yg = y.reshape(b, L, SSD_NGROUPS, SSD_INNER // SSD_NGROUPS)
    yg = yg * lax.rsqrt(jnp.mean(yg * yg, axis=-1, keepdims=True) + EPS)
    y = yg.reshape(b, L, SSD_INNER) * p["ssd_norm"].astype(jnp.float32)
    return y.astype(u.dtype), s_f, s_b


def context_attention(q, k, v):
    b, L, H, dh = q.shape
    scale = dh ** -0.5
    qb = jnp.moveaxis(q.reshape(b, L // Q_BLOCK, Q_BLOCK, H, dh), 1, 0)

    def block(q_blk):
        s = jnp.einsum("bqhd,bkhd->bhqk", q_blk, k).astype(jnp.float32) * scale
        pr = jax.nn.softmax(s, axis=-1).astype(v.dtype)
        return jnp.einsum("bhqk,bkhd->bqhd", pr, v)

    out = lax.map(block, qb)
    return jnp.moveaxis(out, 0, 1).reshape(b, L, H * dh)


def neighbourhood_attention(q, k, v, k_ctx, v_ctx, rpb):
    b, L, H, dh = q.shape
    rows = L // GRID_W
    wr = min(NA_WIN_ROWS, rows)
    scale = dh ** -0.5
    qg = q.reshape(b, rows, GRID_W, H, dh)
    kg = k.reshape(b, rows, GRID_W, H, dh)
    vg = v.reshape(b, rows, GRID_W, H, dh)
    cols = jnp.arange(GRID_W)
    cstart = jnp.clip(cols - NA_WIN_COLS // 2, 0, GRID_W - NA_WIN_COLS)
    col_in = (cols[None, :] >= cstart[:, None]) & (cols[None, :] < cstart[:, None] + NA_WIN_COLS)
    dc_idx = jnp.clip(cols[None, :] - cols[:, None] + NA_WIN_COLS - 1, 0, 2 * NA_WIN_COLS - 2)
    rpb32 = rpb.astype(jnp.float32)

    def row_block(r):
        rs = jnp.clip(r - wr // 2, 0, rows - wr)
        q_r = lax.dynamic_index_in_dim(qg, r, axis=1, keepdims=False)
        k_r = lax.dynamic_slice_in_dim(kg, rs, wr, axis=1)
        v_r = lax.dynamic_slice_in_dim(vg, rs, wr, axis=1)
        dr_idx = rs + jnp.arange(wr) - r + NA_WIN_ROWS - 1
        bias = rpb32[:, dr_idx[None, :, None], dc_idx[:, None, :]]
        s_loc = jnp.einsum("bqhd,biwhd->bhqiw", q_r, k_r).astype(jnp.float32) * scale + bias
        s_loc = jnp.where(col_in[:, None, :], s_loc, -jnp.inf)
        s_ctx = jnp.einsum("bqhd,bchd->bhqc", q_r, k_ctx).astype(jnp.float32) * scale
        logits = jnp.concatenate([s_loc.reshape(b, H, GRID_W, wr * GRID_W), s_ctx], axis=-1)
        pr = jax.nn.softmax(logits, axis=-1).astype(v.dtype)
        p_loc = pr[..., :wr * GRID_W].reshape(b, H, GRID_W, wr, GRID_W)
        p_ctx = pr[..., wr * GRID_W:]
        return (jnp.einsum("bhqiw,biwhd->bqhd", p_loc, v_r)
                + jnp.einsum("bhqc,bchd->bqhd", p_ctx, v_ctx))

    out = lax.map(row_block, jnp.arange(rows))
    return jnp.moveaxis(out, 0, 1).reshape(b, L, H * dh)


def split_projection(h, p):
    u = h @ p["w_in"]
    b, L, _ = h.shape
    u_fn = u[..., :FN_WIDTH]
    u_ssd = u[..., FN_WIDTH:FN_WIDTH + SSD_IN]
    q, k, v = [t.reshape(b, L, NA_HEADS, NA_HEAD_DIM)
               for t in jnp.split(u[..., FN_WIDTH + SSD_IN:], 3, axis=-1)]
    return u_fn, u_ssd, q, k, v


def context_mixer(h, p):
    b = h.shape[0]
    u_fn, u_ssd, q, k, v = split_projection(h, p)
    zeros = jnp.zeros((b, SSD_HEADS, SSD_HEAD_DIM, SSD_STATE), jnp.float32)
    y_ssd, s_f, s_b = ssd_mixer(u_ssd, p, zeros, zeros, use_rope=False)
    y = jnp.concatenate([fourier_mix(u_fn), y_ssd, context_attention(q, k, v)], axis=-1) @ p["w_out"]
    return y, (s_f.astype(h.dtype), s_b.astype(h.dtype), k, v)


def latent_mixer(h, p, s_f0, s_b0, k_ctx, v_ctx):
    u_fn, u_ssd, q, k, v = split_projection(h, p)
    y_ssd, _, _ = ssd_mixer(u_ssd, p, s_f0, s_b0, use_rope=True)
    y_na = neighbourhood_attention(q, k, v, k_ctx, v_ctx, p["rpb"])
    y = jnp.concatenate([fourier_mix(u_fn), y_ssd, y_na], axis=-1) @ p["w_out"]
    return y, None


def trunk_layer(x, mods, p, mixer):
    x = half_ffn(x, mods[0], mods[1], mods[2], p["norm_pre"][0], p["norm_post"][0], p["w13"][0], p["w2"][0])
    h = modulated_norm(x, p["norm_pre"][1], mods[3], mods[4])
    y, extra = mixer(h)
    x = x + mods[5] * rmsnorm(y, p["norm_post"][1])
    x = half_ffn(x, mods[6], mods[7], mods[8], p["norm_pre"][2], p["norm_post"][2], p["w13"][1], p["w2"][1])
    return x, extra


def setup_inputs(seed: int = 0) -> dict:
    key = jax.random.key(seed)
    ks = jax.random.split(key, 24)
    f32 = jnp.float32
    nrm = lambda k, shape, s: jax.random.normal(k, shape, f32) * s
    dt0 = jnp.exp(jax.random.uniform(ks[17], (DEPTH, 2, SSD_HEADS), f32, math.log(1e-3), math.log(1e-1)))
    return {
        "x_prompt": nrm(ks[0], (BATCH, SEQ, D_MODEL), 1.0),
        "x_sample": nrm(ks[1], (DEC_BATCH, DEC_SEQ, D_MODEL), 1.0),
        "c": nrm(ks[2], (DEC_BATCH, D_MODEL), 1.0),
        "state_ssd_fwd": nrm(ks[3], (DEC_BATCH, DEPTH, SSD_HEADS, SSD_HEAD_DIM, SSD_STATE), 0.5),
        "state_ssd_bwd": nrm(ks[4], (DEC_BATCH, DEPTH, SSD_HEADS, SSD_HEAD_DIM, SSD_STATE), 0.5),
        "cache_attn_k": nrm(ks[5], (DEC_BATCH, DEPTH, PAST_LEN, NA_HEADS, NA_HEAD_DIM), 1.0),
        "cache_attn_v": nrm(ks[6], (DEC_BATCH, DEPTH, PAST_LEN, NA_HEADS, NA_HEAD_DIM), 1.0),
        "c_ctx": nrm(ks[7], (D_MODEL,), 1.0),
        "mod_w": nrm(ks[8], (DEPTH, D_MODEL, N_MOD * D_MODEL), 0.5 * D_MODEL ** -0.5),
        "mod_b": nrm(ks[9], (DEPTH, N_MOD * D_MODEL), 0.02),
        "norm_pre": 1.0 + nrm(ks[10], (DEPTH, 3, D_MODEL), 0.05),
        "norm_post": 1.0 + nrm(ks[11], (DEPTH, 3, D_MODEL), 0.05),
        "ffn_w13": nrm(ks[12], (DEPTH, 2, D_MODEL, 2 * FF_HIDDEN), D_MODEL ** -0.5),
        "ffn_w2": nrm(ks[13], (DEPTH, 2, FF_HIDDEN, D_MODEL), FF_HIDDEN ** -0.5),
        "w_in": nrm(ks[14], (DEPTH, D_MODEL, IN_COLS), D_MODEL ** -0.5),
        "w_out": nrm(ks[15], (DEPTH, MIX_WIDTH, D_MODEL), MIX_WIDTH ** -0.5),
        "ssd_conv_w": nrm(ks[16], (DEPTH, SSD_CONV, SSD_CONV_DIM), SSD_CONV ** -0.5),
        "ssd_conv_b": nrm(ks[18], (DEPTH, SSD_CONV_DIM), 0.01),
        "ssd_dt_bias": dt0 + jnp.log(-jnp.expm1(-dt0)),
        "ssd_a_log": jnp.log(jax.random.uniform(ks[19], (DEPTH, 2, SSD_HEADS), f32, 1.0, 16.0)),
        "ssd_d": 1.0 + nrm(ks[20], (DEPTH, SSD_HEADS), 0.1),
        "ssd_norm": 1.0 + nrm(ks[21], (DEPTH, SSD_INNER), 0.05),
        "na_rpb": nrm(ks[22], (DEPTH, NA_HEADS, 2 * NA_WIN_ROWS - 1, 2 * NA_WIN_COLS - 1), 0.1),
    }


def reference(x_prompt, x_sample, c, state_ssd_fwd, state_ssd_bwd, cache_attn_k, cache_attn_v,
              c_ctx, mod_w, mod_b, norm_pre, norm_post, ffn_w13, ffn_w2, w_in, w_out,
              ssd_conv_w, ssd_conv_b, ssd_dt_bias, ssd_a_log, ssd_d, ssd_norm, na_rpb):
    xp = x_prompt
    xs = x_sample
    new_sf, new_sb, new_k, new_v = [], [], [], []
    for l in range(DEPTH):
        p = {"w_in": w_in[l], "w_out": w_out[l], "norm_pre": norm_pre[l], "norm_post": norm_post[l],
             "w13": ffn_w13[l], "w2": ffn_w2[l], "conv_w": ssd_conv_w[l], "conv_b": ssd_conv_b[l],
             "dt_bias": ssd_dt_bias[l], "a_log": ssd_a_log[l], "d": ssd_d[l], "ssd_norm": ssd_norm[l],
             "rpb": na_rpb[l]}
        m_ctx = (jax.nn.silu(c_ctx) @ mod_w[l] + mod_b[l]).reshape(N_MOD, D_MODEL)
        mods_ctx = [m_ctx[i] for i in range(N_MOD)]
        xp, (s_f, s_b, k_c, v_c) = trunk_layer(xp, mods_ctx, p, lambda h, p=p: context_mixer(h, p))
        new_sf.append(s_f)
        new_sb.append(s_b)
        new_k.append(k_c)
        new_v.append(v_c)
        m_lat = (jax.nn.silu(c) @ mod_w[l] + mod_b[l]).reshape(c.shape[0], N_MOD, 1, D_MODEL)
        mods_lat = [m_lat[:, i] for i in range(N_MOD)]
        xs, _ = trunk_layer(xs, mods_lat, p,
                            lambda h, p=p, l=l: latent_mixer(h, p, state_ssd_fwd[:, l], state_ssd_bwd[:, l],
                                                             cache_attn_k[:, l], cache_attn_v[:, l]))
    new_state_ssd_fwd = jnp.stack(new_sf, axis=1)
    new_state_ssd_bwd = jnp.stack(new_sb, axis=1)
    new_cache_attn_k = jnp.stack(new_k, axis=1)
    new_cache_attn_v = jnp.stack(new_v, axis=1)
    return (xp, xs, new_state_ssd_fwd, new_state_ssd_bwd, new_cache_attn_k, new_cache_attn_v)
```

```cpp
#include <hip/hip_runtime.h>
#include <hip/hip_cooperative_groups.h>
#include <cstdio>
#include <cstdint>
namespace cg = cooperative_groups;

typedef unsigned short bf16_t;
typedef __attribute__((ext_vector_type(8))) short bf16x8;
typedef __attribute__((ext_vector_type(4))) float f32x4;
typedef __attribute__((ext_vector_type(16))) float f32x16;
typedef __attribute__((ext_vector_type(4))) unsigned u32x4;

constexpr int NTOK = 16384;
constexpr int NCTX = 8192;
constexpr int LDU = 2192;
constexpr int U_Z = 0, U_XBC = 384, U_DT = 1024, U_Q = 1040, U_K = 1424, U_V = 1808;
constexpr int SMEM_BYTES = 68096;

constexpr size_t OFF_WT13 = 0;
constexpr size_t OFF_WT2 = OFF_WT13 + (size_t)4 * 5632 * 1024 * 2;
constexpr size_t OFF_WTIN = OFF_WT2 + (size_t)4 * 1024 * 2816 * 2;
constexpr size_t OFF_WTOUT = OFF_WTIN + (size_t)2 * 2816 * 1024 * 2;
constexpr size_t OFF_MODS = OFF_WTOUT + (size_t)2 * 1024 * 1024 * 2;
constexpr size_t OFF_DFTS = OFF_MODS + (size_t)2 * 5 * 9216 * 4;
constexpr size_t OFF_DFTL = OFF_DFTS + (size_t)256 * 512 * 2;
constexpr size_t OFF_H = OFF_DFTL + (size_t)2048 * 4096 * 2;
constexpr size_t OFF_Y = OFF_H + (size_t)NTOK * 1024 * 2;
constexpr size_t OFF_R1 = OFF_Y + (size_t)NTOK * 1024 * 2;
constexpr size_t OFF_ACT = OFF_R1;
constexpr size_t OFF_U = OFF_R1;
constexpr size_t OFF_ABC = OFF_U + (size_t)NTOK * LDU * 2;
constexpr size_t OFF_ABL = OFF_ABC + (size_t)32 * 256 * 512 * 2;
constexpr size_t OFF_MIX = OFF_ABL + (size_t)4 * 256 * 4096 * 2;
constexpr size_t OFF_SC = OFF_MIX + (size_t)NTOK * 1024 * 2;
constexpr size_t OFF_SL = OFF_SC + (size_t)32 * 4 * 6 * 2 * 4096 * 4;
constexpr size_t OFF_DC = OFF_SL + (size_t)4 * 32 * 6 * 2 * 4096 * 4;
constexpr size_t OFF_DL = OFF_DC + (size_t)32 * 4 * 12 * 4;
constexpr size_t WS_NEED = OFF_DL + (size_t)4 * 32 * 12 * 4;

constexpr size_t OUT_SF = (size_t)2 * 8192 * 1024;
constexpr size_t OUT_SB = OUT_SF + (size_t)32 * 2 * 6 * 4096;
constexpr size_t OUT_CK = OUT_SB + (size_t)32 * 2 * 6 * 4096;
constexpr size_t OUT_CV = OUT_CK + (size_t)32 * 2 * 256 * 384;

struct Params {
  const float *x_prompt, *x_sample, *c, *st_f, *st_b, *ck, *cv, *c_ctx, *mod_w, *mod_b, *norm_pre, *norm_post,
      *w13, *w2, *w_in, *w_out, *conv_w, *conv_b, *dt_bias, *a_log, *ssd_d, *ssd_norm, *rpb;
  float* out;
  char* ws;
};

__device__ __forceinline__ int otid() { int t = threadIdx.x; asm volatile("" : "+v"(t)); return t; }
__device__ __forceinline__ unsigned f2bf(float f) {
  unsigned u = __float_as_uint(f);
  u += 0x7fffu + ((u >> 16) & 1u);
  return u >> 16;
}
__device__ __forceinline__ float bf2f(bf16_t h) { return __uint_as_float(((unsigned)h) << 16); }
__device__ __forceinline__ unsigned pack2(float a, float b) { return f2bf(a) | (f2bf(b) << 16); }
__device__ __forceinline__ void unpack8(uint4 r, float (&f)[8]) {
  f[0] = __uint_as_float(r.x << 16); f[1] = __uint_as_float(r.x & 0xffff0000u);
  f[2] = __uint_as_float(r.y << 16); f[3] = __uint_as_float(r.y & 0xffff0000u);
  f[4] = __uint_as_float(r.z << 16); f[5] = __uint_as_float(r.z & 0xffff0000u);
  f[6] = __uint_as_float(r.w << 16); f[7] = __uint_as_float(r.w & 0xffff0000u);
}
__device__ __forceinline__ uint4 pack8(const float (&f)[8]) {
  uint4 r;
  r.x = pack2(f[0], f[1]); r.y = pack2(f[2], f[3]); r.z = pack2(f[4], f[5]); r.w = pack2(f[6], f[7]);
  return r;
}
__device__ __forceinline__ bf16x8 as_frag(uint4 r) { return __builtin_bit_cast(bf16x8, r); }
__device__ __forceinline__ float silu_f(float x) { return x / (1.f + __expf(-x)); }
__device__ __forceinline__ float wave_sum(float v) {
#pragma unroll
  for (int o = 32; o > 0; o >>= 1) v += __shfl_xor(v, o, 64);
  return v;
}
__device__ __forceinline__ float grp16_sum(float v) {
#pragma unroll
  for (int o = 8; o > 0; o >>= 1) v += __shfl_xor(v, o, 64);
  return v;
}
__device__ __forceinline__ float grp16_max(float v) {
#pragma unroll
  for (int o = 8; o > 0; o >>= 1) v = fmaxf(v, __shfl_xor(v, o, 64));
  return v;
}

__device__ __forceinline__ int map_w13(int j) {
  int q = j >> 6, r = j & 63;
  return r < 32 ? q * 32 + r : 2816 + q * 32 + (r - 32);
}
__device__ __forceinline__ int map_win(int n) {
  if (n < 896) return 256 + (n - 512);
  if (n < 1536) return 640 + (n - 896);
  if (n < 1552) { int d = n - 1536; return d < 12 ? 1280 + d : -1; }
  if (n < 1936) return 1292 + (n - 1552);
  if (n < 2320) return 1676 + (n - 1936);
  if (n < 2704) return 2060 + (n - 2320);
  return -1;
}

__device__ void xpose_tile(const float* __restrict__ src, int lds_, bf16_t* __restrict__ dst, int ldd, int k0, int n0,
                           int mapkind, float* tile) {
  const int tid = otid(), a = tid & 63, b = tid >> 6;
  const int n = n0 + a;
  const int sc = mapkind == 0 ? map_w13(n) : (mapkind == 2 ? map_win(n) : n);
  __syncthreads();
#pragma unroll 4
  for (int i = 0; i < 16; i++) {
    int kk = b + 4 * i;
    float v = sc >= 0 ? src[(size_t)(k0 + kk) * lds_ + sc] : 0.f;
    tile[kk * 65 + a] = v;
  }
  __syncthreads();
#pragma unroll 4
  for (int i = 0; i < 16; i++) {
    int nn = b + 4 * i;
    dst[(size_t)(n0 + nn) * ldd + k0 + a] = (bf16_t)f2bf(tile[a * 65 + nn]);
  }
}

__device__ void fourier_w_tile(const float* __restrict__ win, bf16_t* __restrict__ dst, int k0, int n0, float* tile) {
  const int tid = otid(), a = tid & 63, b = tid >> 6;
  const int part = n0 >> 8, g = (n0 >> 6) & 3;
  float* trig = tile + 64 * 65;
  __syncthreads();
#pragma unroll 4
  for (int i = 0; i < 16; i++) {
    int kk = b + 4 * i;
    tile[kk * 65 + a] = win[(size_t)(k0 + kk) * 2444 + g * 64 + a];
  }
  if (tid < 64) {
    float ang = (float)tid * (6.283185307179586f / 64.f);
    trig[tid] = part ? __sinf(ang) : __cosf(ang);
  }
  __syncthreads();
  for (int i = 0; i < 16; i++) {
    int m = b + 4 * i;
    float acc = 0.f;
#pragma unroll 8
    for (int c = 0; c < 64; c++) acc += tile[a * 65 + c] * trig[(m * c) & 63];
    dst[(size_t)(n0 + m) * 1024 + k0 + a] = (bf16_t)f2bf(acc);
  }
}

__device__ void mods_item(const Params& p, int item, float* sm) {
  const int tid = otid();
  const int l = item / 144, cgp = item % 144;
  float* sv = sm;
  float* red = sm + 5 * 1024;
  __syncthreads();
  for (int i = tid; i < 5 * 1024; i += 256) {
    int v = i >> 10, k = i & 1023;
    float x = v == 0 ? p.c_ctx[k] : p.c[(v - 1) * 1024 + k];
    sv[i] = silu_f(x);
  }
  __syncthreads();
  const int kg = tid >> 6, jj = tid & 63;
  float acc0 = 0.f, acc1 = 0.f, acc2 = 0.f, acc3 = 0.f, acc4 = 0.f;
  const float* wp = p.mod_w + (size_t)l * 1024 * 9216 + cgp * 64 + jj;
#pragma unroll 8
  for (int k = kg * 256; k < kg * 256 + 256; k++) {
    float wv = wp[(size_t)k * 9216];
    acc0 += sv[k] * wv; acc1 += sv[1024 + k] * wv; acc2 += sv[2048 + k] * wv; acc3 += sv[3072 + k] * wv;
    acc4 += sv[4096 + k] * wv;
  }
  red[(kg * 5 + 0) * 64 + jj] = acc0; red[(kg * 5 + 1) * 64 + jj] = acc1; red[(kg * 5 + 2) * 64 + jj] = acc2;
  red[(kg * 5 + 3) * 64 + jj] = acc3; red[(kg * 5 + 4) * 64 + jj] = acc4;
  __syncthreads();
  float* mods = (float*)(p.ws + OFF_MODS);
  for (int i = tid; i < 320; i += 256) {
    int v = i >> 6, j2 = i & 63;
    float s = red[(0 * 5 + v) * 64 + j2] + red[(1 * 5 + v) * 64 + j2] + red[(2 * 5 + v) * 64 + j2] +
              red[(3 * 5 + v) * 64 + j2];
    s += p.mod_b[l * 9216 + cgp * 64 + j2];
    mods[(size_t)(l * 5 + v) * 9216 + cgp * 64 + j2] = s;
  }
}

__device__ void dft_item(const Params& p, int item) {
  const int tid = otid();
  int L, e0; bf16_t* dst;
  if (item < 64) { L = 256; e0 = item * 2048 + tid * 8; dst = (bf16_t*)(p.ws + OFF_DFTS); }
  else { L = 2048; e0 = (item - 64) * 2048 + tid * 8; dst = (bf16_t*)(p.ws + OFF_DFTL); }
  const int k = e0 / (2 * L), t0 = e0 % (2 * L);
  const float sc = rsqrtf(64.f * (float)L);
  const float w = 6.283185307179586f / (float)L;
  float f[8];
#pragma unroll
  for (int j = 0; j < 8; j++) {
    int tt = t0 + j;
    bool isin = tt >= L;
    int t = isin ? tt - L : tt;
    int r = (k * t) & (L - 1);
    float ang = (float)r * w;
    f[j] = isin ? -__sinf(ang) * sc : __cosf(ang) * sc;
  }
  *(uint4*)(dst + (size_t)e0) = pack8(f);
}

__device__ void phase0(const Params& p, char* smem) {
  float* tile = (float*)smem;
  constexpr int PER_L = 2816 + 1408 + 576 + 128 + 256;
  constexpr int N_X = 2 * PER_L;
  constexpr int N_M = 288;
  constexpr int N_D = 64 + 4096;
  for (int item = blockIdx.x; item < N_X + N_M + N_D; item += gridDim.x) {
    if (item < N_X) {
      int l = item / PER_L, r = item % PER_L;
      if (r < 2816) {
        int s = r / 1408, q = r % 1408;
        int nt = q / 16, kt = q % 16;
        xpose_tile(p.w13 + (size_t)(l * 2 + s) * 1024 * 5632, 5632,
                   (bf16_t*)(p.ws + OFF_WT13) + (size_t)(l * 2 + s) * 5632 * 1024, 1024, kt * 64, nt * 64, 0, tile);
      } else if (r < 2816 + 1408) {
        int q0 = r - 2816;
        int s = q0 / 704, q = q0 % 704;
        int nt = q / 44, kt = q % 44;
        xpose_tile(p.w2 + (size_t)(l * 2 + s) * 2816 * 1024, 1024,
                   (bf16_t*)(p.ws + OFF_WT2) + (size_t)(l * 2 + s) * 1024 * 2816, 2816, kt * 64, nt * 64, 1, tile);
      } else if (r < 2816 + 1408 + 576) {
        int q = r - 2816 - 1408;
        int nt = q / 16, kt = q % 16;
        xpose_tile(p.w_in + (size_t)l * 1024 * 2444, 2444, (bf16_t*)(p.ws + OFF_WTIN) + (size_t)l * 2816 * 1024, 1024,
                   kt * 64, 512 + nt * 64, 2, tile);
      } else if (r < 2816 + 1408 + 576 + 128) {
        int q = r - 2816 - 1408 - 576;
        int nt = q / 16, kt = q % 16;
        fourier_w_tile(p.w_in + (size_t)l * 1024 * 2444, (bf16_t*)(p.ws + OFF_WTIN) + (size_t)l * 2816 * 1024, kt * 64,
                       nt * 64, tile);
      } else {
        int q = r - 2816 - 1408 - 576 - 128;
        int nt = q / 16, kt = q % 16;
        xpose_tile(p.w_out + (size_t)l * 1024 * 1024, 1024, (bf16_t*)(p.ws + OFF_WTOUT) + (size_t)l * 1024 * 1024, 1024,
                   kt * 64, nt * 64, 1, tile);
      }
    } else if (item < N_X + N_M) {
      mods_item(p, item - N_X, tile);
    } else {
      dft_item(p, item - N_X - N_M);
    }
  }
}

__device__ void rowpass(const Params& p, const float* __restrict__ xc, const float* __restrict__ xl, bool has_post,
                        int lpost, int gi, const float* __restrict__ gpost, float mult, bool has_pre, int lpre, int si,
                        const float* __restrict__ gpre) {
  const bf16_t* y = (const bf16_t*)(p.ws + OFF_Y);
  bf16_t* h = (bf16_t*)(p.ws + OFF_H);
  const float* mods = (const float*)(p.ws + OFF_MODS);
  const int wave = otid() >> 6, lane = otid() & 63;
  for (int row = blockIdx.x * 4 + wave; row < NTOK; row += gridDim.x * 4) {
    const int v = row < NCTX ? 0 : 1 + ((row - NCTX) >> 11);
    const float* xr = row < NCTX ? xc + (size_t)row * 1024 : xl + (size_t)(row - NCTX) * 1024;
    float4 xv[4];
#pragma unroll
    for (int it = 0; it < 4; it++) xv[it] = *(const float4*)(xr + it * 256 + lane * 4);
    if (has_post) {
      float4 yv[4];
      float ss = 0.f;
#pragma unroll
      for (int it = 0; it < 4; it++) {
        uint2 raw = *(const uint2*)(y + (size_t)row * 1024 + it * 256 + lane * 4);
        yv[it].x = __uint_as_float(raw.x << 16); yv[it].y = __uint_as_float(raw.x & 0xffff0000u);
        yv[it].z = __uint_as_float(raw.y << 16); yv[it].w = __uint_as_float(raw.y & 0xffff0000u);
        ss += yv[it].x * yv[it].x + yv[it].y * yv[it].y + yv[it].z * yv[it].z + yv[it].w * yv[it].w;
      }
      ss = wave_sum(ss);
      const float r = rsqrtf(ss * (1.f / 1024.f) + 1e-6f) * mult;
      const float* gm = mods + (size_t)(lpost * 5 + v) * 9216 + gi * 1024;
#pragma unroll
      for (int it = 0; it < 4; it++) {
        float4 g = *(const float4*)(gm + it * 256 + lane * 4);
        float4 gp = *(const float4*)(gpost + it * 256 + lane * 4);
        xv[it].x += g.x * (yv[it].x * r * gp.x); xv[it].y += g.y * (yv[it].y * r * gp.y);
        xv[it].z += g.z * (yv[it].z * r * gp.z); xv[it].w += g.w * (yv[it].w * r * gp.w);
        *(float4*)(p.out + (size_t)row * 1024 + it * 256 + lane * 4) = xv[it];
      }
    }
    if (has_pre) {
      float ss = 0.f;
#pragma unroll
      for (int it = 0; it < 4; it++)
        ss += xv[it].x * xv[it].x + xv[it].y * xv[it].y + xv[it].z * xv[it].z + xv[it].w * xv[it].w;
      ss = wave_sum(ss);
      const float r = rsqrtf(ss * (1.f / 1024.f) + 1e-6f);
      const float* sh = mods + (size_t)(lpre * 5 + v) * 9216 + si * 1024;
      const float* scp = sh + 1024;
#pragma unroll
      for (int it = 0; it < 4; it++) {
        float4 g = *(const float4*)(gpre + it * 256 + lane * 4);
        float4 s4 = *(const float4*)(sh + it * 256 + lane * 4);
        float4 c4 = *(const float4*)(scp + it * 256 + lane * 4);
        float h0 = xv[it].x * r * g.x * (1.f + c4.x) + s4.x;
        float h1 = xv[it].y * r * g.y * (1.f + c4.y) + s4.y;
        float h2 = xv[it].z * r * g.z * (1.f + c4.z) + s4.z;
        float h3 = xv[it].w * r * g.w * (1.f + c4.w) + s4.w;
        uint2 o; o.x = pack2(h0, h1); o.y = pack2(h2, h3);
        *(uint2*)(h + (size_t)row * 1024 + it * 256 + lane * 4) = o;
      }
    }
  }
}

__device__ __forceinline__ void gemm_core(const bf16_t* __restrict__ A, int lda, const bf16_t* __restrict__ Bt, int ldb,
                                          int K, f32x16 (&acc)[2][2], char* smem) {
  bf16_t* As = (bf16_t*)smem;
  bf16_t* Bs = As + 128 * 72;
  const int tid = otid(), lane = tid & 63, w = tid >> 6, wm = w >> 1, wn = w & 1;
  const int lr = tid >> 3, lc = tid & 7;
  const bf16_t* ap = A + (size_t)lr * lda + lc * 8;
  const bf16_t* bp = Bt + (size_t)lr * ldb + lc * 8;
  u32x4 ra[4], rb[4];
#pragma unroll
  for (int i = 0; i < 4; i++) {
    ra[i] = *(const u32x4*)(ap + (size_t)(32 * i) * lda);
    rb[i] = *(const u32x4*)(bp + (size_t)(32 * i) * ldb);
  }
#pragma unroll
  for (int mi = 0; mi < 2; mi++)
#pragma unroll
    for (int ni = 0; ni < 2; ni++)
#pragma unroll
      for (int r = 0; r < 16; r++) acc[mi][ni][r] = 0.f;
  const int KT = K >> 6;
  const int fr = lane & 31, fk = (lane >> 5) * 8;
  for (int kt = 0; kt < KT; kt++) {
    __syncthreads();
#pragma unroll
    for (int i = 0; i < 4; i++) {
      *(u32x4*)(As + (lr + 32 * i) * 72 + lc * 8) = ra[i];
      *(u32x4*)(Bs + (lr + 32 * i) * 72 + lc * 8) = rb[i];
    }
    __syncthreads();
    if (kt + 1 < KT) {
#pragma unroll
      for (int i = 0; i < 4; i++) {
        ra[i] = *(const u32x4*)(ap + (size_t)(32 * i) * lda + (kt + 1) * 64);
        rb[i] = *(const u32x4*)(bp + (size_t)(32 * i) * ldb + (kt + 1) * 64);
      }
    }
#pragma unroll
    for (int ks = 0; ks < 4; ks++) {
      bf16x8 af[2], bfr[2];
#pragma unroll
      for (int mi = 0; mi < 2; mi++) af[mi] = *(const bf16x8*)(As + (wm * 64 + mi * 32 + fr) * 72 + ks * 16 + fk);
#pragma unroll
      for (int ni = 0; ni < 2; ni++) bfr[ni] = *(const bf16x8*)(Bs + (wn * 64 + ni * 32 + fr) * 72 + ks * 16 + fk);
#pragma unroll
      for (int mi = 0; mi < 2; mi++)
#pragma unroll
        for (int ni = 0; ni < 2; ni++)
          acc[mi][ni] = __builtin_amdgcn_mfma_f32_32x32x16_bf16(af[mi], bfr[ni], acc[mi][ni], 0, 0, 0);
    }
  }
}

__device__ __forceinline__ void epi_bf16(const f32x16 (&acc)[2][2], bf16_t* __restrict__ C, int ldc) {
  const int lane = otid() & 63, w = otid() >> 6, wm = w >> 1, wn = w & 1;
#pragma unroll
  for (int mi = 0; mi < 2; mi++)
#pragma unroll
    for (int ni = 0; ni < 2; ni++)
#pragma unroll
      for (int r = 0; r < 16; r++) {
        int row = wm * 64 + mi * 32 + (r & 3) + 8 * (r >> 2) + 4 * (lane >> 5);
        int col = wn * 64 + ni * 32 + (lane & 31);
        C[(size_t)row * ldc + col] = (bf16_t)f2bf(acc[mi][ni][r]);
      }
}

template <int KIND>
__device__ void gemm_phase(const Params& p, int l, int s, char* smem) {
  const bf16_t* A; const bf16_t* Bt; int lda, ldb, K, NTN;
  if (KIND == 0) { A = (const bf16_t*)(p.ws + OFF_H); lda = 1024; Bt = (const bf16_t*)(p.ws + OFF_WT13) + (size_t)(l * 2 + s) * 5632 * 1024; ldb = 1024; K = 1024; NTN = 44; }
  else if (KIND == 1) { A = (const bf16_t*)(p.ws + OFF_ACT); lda = 2816; Bt = (const bf16_t*)(p.ws + OFF_WT2) + (size_t)(l * 2 + s) * 1024 * 2816; ldb = 2816; K = 2816; NTN = 8; }
  else if (KIND == 2) { A = (const bf16_t*)(p.ws + OFF_H); lda = 1024; Bt = (const bf16_t*)(p.ws + OFF_WTIN) + (size_t)l * 2816 * 1024; ldb = 1024; K = 1024; NTN = 22; }
  else { A = (const bf16_t*)(p.ws + OFF_MIX); lda = 1024; Bt = (const bf16_t*)(p.ws + OFF_WTOUT) + (size_t)l * 1024 * 1024; ldb = 1024; K = 1024; NTN = 8; }
  const int lane = otid() & 63, w = otid() >> 6, wm = w >> 1, wn = w & 1;
  for (int tile = blockIdx.x; tile < 128 * NTN; tile += gridDim.x) {
    const int tm = tile & 127, tn = tile >> 7;
    const int m0 = tm * 128, n0 = tn * 128;
    f32x16 acc[2][2];
    gemm_core(A + (size_t)m0 * lda, lda, Bt + (size_t)n0 * ldb, ldb, K, acc, smem);
    if (KIND == 0) {
      bf16_t* act = (bf16_t*)(p.ws + OFF_ACT);
#pragma unroll
      for (int mi = 0; mi < 2; mi++)
#pragma unroll
        for (int r = 0; r < 16; r++) {
          int row = m0 + wm * 64 + mi * 32 + (r & 3) + 8 * (r >> 2) + 4 * (lane >> 5);
          int col = (n0 >> 1) + wn * 32 + (lane & 31);
          float g = acc[mi][0][r], u = acc[mi][1][r];
          act[(size_t)row * 2816 + col] = (bf16_t)f2bf(silu_f(g) * u);
        }
    } else if (KIND == 1 || KIND == 3) {
      epi_bf16(acc, (bf16_t*)(p.ws + OFF_Y) + (size_t)m0 * 1024 + n0, 1024);
    } else {
      if (tn < 4) {
        const int part = tn >> 1;
        bf16_t* base; int L, t0;
        if (m0 < NCTX) { L = 256; base = (bf16_t*)(p.ws + OFF_ABC) + (size_t)(m0 >> 8) * 256 * 512; t0 = m0 & 255; }
        else { L = 2048; int mm = m0 - NCTX; base = (bf16_t*)(p.ws + OFF_ABL) + (size_t)(mm >> 11) * 256 * 4096; t0 = mm & 2047; }
#pragma unroll
        for (int mi = 0; mi < 2; mi++)
#pragma unroll
          for (int ni = 0; ni < 2; ni++)
#pragma unroll
            for (int rq = 0; rq < 4; rq++) {
              int n = (n0 & 255) + wn * 64 + ni * 32 + (lane & 31);
              int t = t0 + wm * 64 + mi * 32 + 8 * rq + 4 * (lane >> 5);
              uint2 o;
              o.x = pack2(acc[mi][ni][rq * 4 + 0], acc[mi][ni][rq * 4 + 1]);
              o.y = pack2(acc[mi][ni][rq * 4 + 2], acc[mi][ni][rq * 4 + 3]);
              *(uint2*)(base + (size_t)n * (2 * L) + part * L + t) = o;
            }
      } else {
        bf16_t* U = (bf16_t*)(p.ws + OFF_U);
#pragma unroll
        for (int mi = 0; mi < 2; mi++)
#pragma unroll
          for (int ni = 0; ni < 2; ni++) {
            const int col = n0 + wn * 64 + ni * 32 + (lane & 31);
            if (col < 2704) {
#pragma unroll
              for (int r = 0; r < 16; r++) {
                int row = m0 + wm * 64 + mi * 32 + (r & 3) + 8 * (r >> 2) + 4 * (lane >> 5);
                float v = acc[mi][ni][r];
                U[(size_t)row * LDU + (col - 512)] = (bf16_t)f2bf(v);
                if (row < NCTX && col >= 1936) {
                  int b = row >> 8, t = row & 255;
                  if (col < 2320) p.out[OUT_CK + ((size_t)((b * 2 + l) * 256 + t)) * 384 + (col - 1936)] = v;
                  else p.out[OUT_CV + ((size_t)((b * 2 + l) * 256 + t)) * 384 + (col - 2320)] = v;
                }
              }
            }
          }
      }
    }
  }
}

__device__ void fourier_tile(const Params& p, int item, char* smem) {
  const bf16_t* A; const bf16_t* Bt; int K; bf16_t* C;
  if (item < 128) {
    int b = item >> 5, tm = (item >> 1) & 15, tn = item & 1;
    A = (const bf16_t*)(p.ws + OFF_DFTL) + (size_t)tm * 128 * 4096;
    Bt = (const bf16_t*)(p.ws + OFF_ABL) + ((size_t)b * 256 + tn * 128) * 4096;
    K = 4096;
    C = (bf16_t*)(p.ws + OFF_MIX) + ((size_t)NCTX + b * 2048 + tm * 128) * 1024 + tn * 128;
  } else {
    int it = item - 128;
    int b = it >> 2, tm = (it >> 1) & 1, tn = it & 1;
    A = (const bf16_t*)(p.ws + OFF_DFTS) + (size_t)tm * 128 * 512;
    Bt = (const bf16_t*)(p.ws + OFF_ABC) + ((size_t)b * 256 + tn * 128) * 512;
    K = 512;
    C = (bf16_t*)(p.ws + OFF_MIX) + ((size_t)b * 256 + tm * 128) * 1024 + tn * 128;
  }
  f32x16 acc[2][2];
  gemm_core(A, K, Bt, K, K, acc, smem);
  epi_bf16(acc, C, 1024);
}

__device__ void attn_tile(const Params& p, int l, int item, char* smem) {
  bf16_t* Qs = (bf16_t*)smem;
  bf16_t* Ks = Qs + 64 * 72;
  bf16_t* Vt = Ks + 64 * 72;
  bf16_t* Ps = Vt + 64 * 72;
  float* rp = (float*)(Ps + 64 * 72);
  const bf16_t* U = (const bf16_t*)(p.ws + OFF_U);
  const int tid = otid(), lane = tid & 63, w = tid >> 6;
  bool lat; int b, h, r = 0, rs = 0, rowq, nch;
  if (item < 768) { lat = true; b = item / 192; h = (item / 32) % 6; r = item & 31; rs = min(max(r - 4, 0), 24); rowq = NCTX + b * 2048 + r * 64; nch = 16; }
  else { int it = item - 768; lat = false; b = it / 24; h = (it >> 2) % 6; int qb = it & 3; rowq = b * 256 + qb * 64; nch = 4; }
  const int li = tid >> 2, seg = (tid & 3) * 16;
  __syncthreads();
  {
    const bf16_t* qp = U + (size_t)(rowq + li) * LDU + U_Q + h * 64 + seg;
    uint4 q0 = *(const uint4*)qp, q1 = *(const uint4*)(qp + 8);
    float f[8];
    unpack8(q0, f);
#pragma unroll
    for (int e = 0; e < 8; e++) f[e] *= 0.125f;
    *(uint4*)(Qs + li * 72 + seg) = pack8(f);
    unpack8(q1, f);
#pragma unroll
    for (int e = 0; e < 8; e++) f[e] *= 0.125f;
    *(uint4*)(Qs + li * 72 + seg + 8) = pack8(f);
    if (lat)
      for (int i = tid; i < 465; i += 256) rp[i] = p.rpb[(size_t)(l * 6 + h) * 465 + i];
  }
  float mrow[4], lsum[4];
  f32x4 oacc[4];
#pragma unroll
  for (int i = 0; i < 4; i++) { mrow[i] = -1e30f; lsum[i] = 0.f; oacc[i] = (f32x4){0.f, 0.f, 0.f, 0.f}; }
  for (int ci = 0; ci < nch; ci++) {
    uint4 k0, k1, v0, v1;
    if (lat && ci >= 8) {
      size_t off = ((size_t)((b * 2 + l) * 512 + (ci - 8) * 64 + li)) * 384 + h * 64 + seg;
      const float* kp = p.ck + off; const float* vp = p.cv + off;
      float4 a0 = *(const float4*)kp, a1 = *(const float4*)(kp + 4), a2 = *(const float4*)(kp + 8), a3 = *(const float4*)(kp + 12);
      k0.x = pack2(a0.x, a0.y); k0.y = pack2(a0.z, a0.w); k0.z = pack2(a1.x, a1.y); k0.w = pack2(a1.z, a1.w);
      k1.x = pack2(a2.x, a2.y); k1.y = pack2(a2.z, a2.w); k1.z = pack2(a3.x, a3.y); k1.w = pack2(a3.z, a3.w);
      a0 = *(const float4*)vp; a1 = *(const float4*)(vp + 4); a2 = *(const float4*)(vp + 8); a3 = *(const float4*)(vp + 12);
      v0.x = pack2(a0.x, a0.y); v0.y = pack2(a0.z, a0.w); v0.z = pack2(a1.x, a1.y); v0.w = pack2(a1.z, a1.w);
      v1.x = pack2(a2.x, a2.y); v1.y = pack2(a2.z, a2.w); v1.z = pack2(a3.x, a3.y); v1.w = pack2(a3.z, a3.w);
    } else {
      int krow = lat ? (NCTX + b * 2048 + (rs + ci) * 64) : (b * 256 + ci * 64);
      const bf16_t* kp = U + (size_t)(krow + li) * LDU + U_K + h * 64 + seg;
      const bf16_t* vp = U + (size_t)(krow + li) * LDU + U_V + h * 64 + seg;
      k0 = *(const uint4*)kp; k1 = *(const uint4*)(kp + 8);
      v0 = *(const uint4*)vp; v1 = *(const uint4*)(vp + 8);
    }
    __syncthreads();
    *(uint4*)(Ks + li * 72 + seg) = k0;
    *(uint4*)(Ks + li * 72 + seg + 8) = k1;
    {
      unsigned vw[8] = {v0.x, v0.y, v0.z, v0.w, v1.x, v1.y, v1.z, v1.w};
#pragma unroll
      for (int e = 0; e < 8; e++) {
        Vt[(seg + 2 * e) * 72 + li] = (bf16_t)(vw[e] & 0xffffu);
        Vt[(seg + 2 * e + 1) * 72 + li] = (bf16_t)(vw[e] >> 16);
      }
    }
    __syncthreads();
    f32x4 sacc[4];
#pragma unroll
    for (int ct = 0; ct < 4; ct++) sacc[ct] = (f32x4){0.f, 0.f, 0.f, 0.f};
#pragma unroll
    for (int ks = 0; ks < 2; ks++) {
      bf16x8 qa = *(const bf16x8*)(Qs + (16 * w + (lane & 15)) * 72 + ks * 32 + (lane >> 4) * 8);
#pragma unroll
      for (int ct = 0; ct < 4; ct++) {
        bf16x8 kb = *(const bf16x8*)(Ks + (16 * ct + (lane & 15)) * 72 + ks * 32 + (lane >> 4) * 8);
        sacc[ct] = __builtin_amdgcn_mfma_f32_16x16x32_bf16(qa, kb, sacc[ct], 0, 0, 0);
      }
    }
    const bool local = lat && ci < 8;
    const int dr = local ? (rs + ci - r + 7) : 0;
#pragma unroll
    for (int rg = 0; rg < 4; rg++) {
      const int qc = 16 * w + 4 * (lane >> 4) + rg;
      float sv[4];
      float mx = -1e30f;
#pragma unroll
      for (int ct = 0; ct < 4; ct++) {
        float sx = sacc[ct][rg];
        if (local) {
          int kc = 16 * ct + (lane & 15);
          int cst = min(max(qc - 8, 0), 48);
          bool valid = (kc >= cst) && (kc < cst + 16);
          int dc = min(max(kc - qc + 15, 0), 30);
          sx = valid ? sx + rp[dr * 31 + dc] : -1e30f;
        }
        sv[ct] = sx;
        mx = fmaxf(mx, sx);
      }
      mx = grp16_max(mx);
      const float mnew = fmaxf(mrow[rg], mx);
      const float alpha = __expf(mrow[rg] - mnew);
      float rsum = 0.f;
#pragma unroll
      for (int ct = 0; ct < 4; ct++) {
        float pv = __expf(sv[ct] - mnew);
        rsum += pv;
        Ps[(w * 16 + 4 * (lane >> 4) + rg) * 72 + 16 * ct + (lane & 15)] = (bf16_t)f2bf(pv);
      }
      rsum = grp16_sum(rsum);
      lsum[rg] = lsum[rg] * alpha + rsum;
      mrow[rg] = mnew;
#pragma unroll
      for (int dt = 0; dt < 4; dt++) oacc[dt][rg] *= alpha;
    }
    __syncthreads();
#pragma unroll
    for (int ks = 0; ks < 2; ks++) {
      bf16x8 pa = *(const bf16x8*)(Ps + (w * 16 + (lane & 15)) * 72 + ks * 32 + (lane >> 4) * 8);
#pragma unroll
      for (int dt = 0; dt < 4; dt++) {
        bf16x8 vb = *(const bf16x8*)(Vt + (16 * dt + (lane & 15)) * 72 + ks * 32 + (lane >> 4) * 8);
        oacc[dt] = __builtin_amdgcn_mfma_f32_16x16x32_bf16(pa, vb, oacc[dt], 0, 0, 0);
      }
    }
  }
  bf16_t* mix = (bf16_t*)(p.ws + OFF_MIX);
#pragma unroll
  for (int rg = 0; rg < 4; rg++) {
    const float inv = 1.f / lsum[rg];
    const int row = rowq + 16 * w + 4 * (lane >> 4) + rg;
#pragma unroll
    for (int dt = 0; dt < 4; dt++)
      mix[(size_t)row * 1024 + 640 + h * 64 + 16 * dt + (lane & 15)] = (bf16_t)f2bf(oacc[dt][rg] * inv);
  }
}

__device__ __forceinline__ void conv8(const bf16_t* __restrict__ U, const float* __restrict__ cw,
                                      const float* __restrict__ cb, int rowbase, int L, int tc, int ch, float (&o)[8]) {
  float4 b0 = *(const float4*)(cb + ch), b1 = *(const float4*)(cb + ch + 4);
  o[0] = b0.x; o[1] = b0.y; o[2] = b0.z; o[3] = b0.w; o[4] = b1.x; o[5] = b1.y; o[6] = b1.z; o[7] = b1.w;
#pragma unroll
  for (int j = 0; j < 5; j++) {
    int tt = tc + j - 2;
    if (tt >= 0 && tt < L) {
      uint4 raw = *(const uint4*)(U + (size_t)(rowbase + tt) * LDU + U_XBC + ch);
      float f[8];
      unpack8(raw, f);
      float4 w0 = *(const float4*)(cw + j * 640 + ch), w1 = *(const float4*)(cw + j * 640 + ch + 4);
      o[0] += w0.x * f[0]; o[1] += w0.y * f[1]; o[2] += w0.z * f[2]; o[3] += w0.w * f[3];
      o[4] += w1.x * f[4]; o[5] += w1.y * f[5]; o[6] += w1.z * f[6]; o[7] += w1.w * f[7];
    }
  }
#pragma unroll
  for (int e = 0; e < 8; e++) o[e] = silu_f(o[e]);
}

struct SsdSm {
  bf16_t* xT;
  bf16_t* Bn;
  bf16_t* Cn;
  bf16_t* BT;
  float* dts;
  float* cs;
  float* wts;
  float* G;
};
__device__ __forceinline__ SsdSm ssd_carve(char* smem) {
  SsdSm s;
  s.xT = (bf16_t*)smem;
  s.Bn = s.xT + 192 * 72;
  s.Cn = s.Bn + 64 * 72;
  s.dts = (float*)(s.Cn + 64 * 72);
  s.cs = s.dts + 384;
  s.wts = s.cs + 384;
  s.BT = (bf16_t*)(s.wts + 384);
  s.G = s.wts + 384;
  return s;
}

__device__ void ssd_load(const Params& p, int l, int rowbase, int L, int t0, int g, bool rope, bool needBT,
                         const SsdSm& s) {
  const bf16_t* U = (const bf16_t*)(p.ws + OFF_U);
  const float* cw = p.conv_w + (size_t)l * 5 * 640;
  const float* cb = p.conv_b + (size_t)l * 640;
  const int tid = otid(), lane = tid & 63, w = tid >> 6;
  __syncthreads();
  for (int unit = tid; unit < 1536; unit += 256) {
    int t = unit / 24, cbk = unit % 24;
    float o[8];
    conv8(U, cw, cb, rowbase, L, t0 + t, 192 * g + cbk * 8, o);
#pragma unroll
    for (int e = 0; e < 8; e++) s.xT[(cbk * 8 + e) * 72 + t] = (bf16_t)f2bf(o[e]);
  }
  for (int unit = tid; unit < 512; unit += 256) {
    int t = unit >> 3, which = (unit >> 2) & 1, pb = unit & 3;
    int q = (pb & 1) * 8 + (pb >> 1) * 32;
    int chb = 384 + which * 128 + g * 64;
    float v1[8], v2[8];
    conv8(U, cw, cb, rowbase, L, t0 + t, chb + q, v1);
    conv8(U, cw, cb, rowbase, L, t0 + t, chb + q + 16, v2);
    if (rope) {
      int tabs = t0 + t;
      float pos = (q < 32) ? (float)(tabs >> 6) : (float)(tabs & 63);
#pragma unroll
      for (int e = 0; e < 8; e++) {
        int idx = (q & 15) + e;
        float inv = exp2f(-(float)idx * (13.287712379549449f / 16.f));
        float ang = pos * inv;
        float cs_ = __cosf(ang), sn = __sinf(ang);
        float a = v1[e], bb = v2[e];
        v1[e] = a * cs_ - bb * sn;
        v2[e] = a * sn + bb * cs_;
      }
    }
    bf16_t* arr = which ? s.Cn : s.Bn;
    *(uint4*)(arr + t * 72 + q) = pack8(v1);
    *(uint4*)(arr + t * 72 + q + 16) = pack8(v2);
    if (which == 0 && needBT) {
#pragma unroll
      for (int e = 0; e < 8; e++) {
        s.BT[(q + e) * 72 + t] = (bf16_t)f2bf(v1[e]);
        s.BT[(q + 16 + e) * 72 + t] = (bf16_t)f2bf(v2[e]);
      }
    }
  }
  for (int i = tid; i < 384; i += 256) {
    int t = i / 6, hh = i % 6;
    int dir = hh / 3, h3 = hh % 3, hd = 3 * g + h3;
    float raw = bf2f(U[(size_t)(rowbase + t0 + t) * LDU + U_DT + dir * 6 + hd]) + p.dt_bias[(l * 2 + dir) * 6 + hd];
    float dt = raw > 20.f ? raw : log1pf(__expf(raw));
    s.dts[(dir * 3 + h3) * 64 + t] = dt;
  }
  __syncthreads();
  for (int sq = w; sq < 6; sq += 4) {
    int dir = sq / 3, h3 = sq % 3;
    float a = -__expf(p.a_log[(l * 2 + dir) * 6 + 3 * g + h3]);
    int t = dir ? 63 - lane : lane;
    float v = s.dts[sq * 64 + t] * a;
#pragma unroll
    for (int o = 1; o < 64; o <<= 1) {
      float n = __shfl_up(v, o, 64);
      if (lane >= o) v += n;
    }
    s.cs[sq * 64 + t] = v;
  }
  __syncthreads();
}

__device__ void ssd_state_tile(const Params& p, int l, int item, char* smem) {
  SsdSm s = ssd_carve(smem);
  const int tid = otid(), lane = tid & 63, w = tid >> 6;
  bool lat; int sq, c, g, NC, L, rowbase; float* S; float* dec;
  if (item < 256) { lat = true; sq = item >> 6; c = (item >> 1) & 31; g = item & 1; NC = 32; L = 2048; rowbase = NCTX + sq * 2048; S = (float*)(p.ws + OFF_SL); dec = (float*)(p.ws + OFF_DL); }
  else { int it = item - 256; lat = false; sq = it >> 3; c = (it >> 1) & 3; g = it & 1; NC = 4; L = 256; rowbase = sq * 256; S = (float*)(p.ws + OFF_SC); dec = (float*)(p.ws + OFF_DC); }
  ssd_load(p, l, rowbase, L, c * 64, g, lat, true, s);
  for (int i = tid; i < 384; i += 256) {
    int q = i >> 6, t = i & 63;
    int dir = q / 3;
    float ce = dir ? s.cs[q * 64 + 0] : s.cs[q * 64 + 63];
    s.wts[i] = __expf(ce - s.cs[i]) * s.dts[i];
  }
  __syncthreads();
#pragma unroll 1
  for (int q = 0; q < 6; q++) {
    const int dir = q / 3, h3 = q % 3;
    f32x4 acc[4];
#pragma unroll
    for (int nt = 0; nt < 4; nt++) acc[nt] = (f32x4){0.f, 0.f, 0.f, 0.f};
#pragma unroll
    for (int ks = 0; ks < 2; ks++) {
      const int tb = ks * 32 + (lane >> 4) * 8;
      uint4 raw = *(const uint4*)(s.xT + (h3 * 64 + 16 * w + (lane & 15)) * 72 + tb);
      float f[8];
      unpack8(raw, f);
#pragma unroll
      for (int e = 0; e < 8; e++) f[e] *= s.wts[q * 64 + tb + e];
      bf16x8 a = as_frag(pack8(f));
#pragma unroll
      for (int nt = 0; nt < 4; nt++) {
        bf16x8 bb = *(const bf16x8*)(s.BT + (16 * nt + (lane & 15)) * 72 + tb);
        acc[nt] = __builtin_amdgcn_mfma_f32_16x16x32_bf16(a, bb, acc[nt], 0, 0, 0);
      }
    }
    const size_t idx = ((size_t)(sq * NC + c) * 6 + 3 * g + h3) * 2 + dir;
    float* So = S + idx * 4096;
#pragma unroll
    for (int nt = 0; nt < 4; nt++)
#pragma unroll
      for (int rg = 0; rg < 4; rg++) So[(16 * w + 4 * (lane >> 4) + rg) * 64 + 16 * nt + (lane & 15)] = acc[nt][rg];
    if (tid == 0) dec[idx] = __expf(dir ? s.cs[q * 64 + 0] : s.cs[q * 64 + 63]);
  }
}

__device__ void ssd_prefix(const Params& p, int l) {
  const int total = 36 * 12 * 4096;
  for (int e = blockIdx.x * 256 + otid(); e < total; e += gridDim.x * 256) {
    const int pn = e & 4095;
    const int r = e >> 12;
    const int dir = r & 1, h = (r >> 1) % 6, sq = r / 12;
    const bool lat = sq >= 32;
    const int sl = lat ? sq - 32 : sq;
    const int NC = lat ? 32 : 4;
    float* S = (float*)(p.ws + (lat ? OFF_SL : OFF_SC));
    const float* dec = (const float*)(p.ws + (lat ? OFF_DL : OFF_DC));
    float run = 0.f;
    if (lat) run = (dir ? p.st_b : p.st_f)[((size_t)(sl * 2 + l) * 6 + h) * 4096 + pn];
    for (int ci = 0; ci < NC; ci++) {
      int c = dir ? NC - 1 - ci : ci;
      size_t idx = ((size_t)(sl * NC + c) * 6 + h) * 2 + dir;
      float sv = S[idx * 4096 + pn];
      float d = dec[idx];
      S[idx * 4096 + pn] = run;
      run = run * d + sv;
    }
    if (!lat) p.out[(dir ? OUT_SB : OUT_SF) + ((size_t)(sl * 2 + l) * 6 + h) * 4096 + pn] = run;
  }
}

__device__ void ssd_out_tile(const Params& p, int l, int item, char* smem) {
  SsdSm s = ssd_carve(smem);
  float* G = s.G;
  const bf16_t* U = (const bf16_t*)(p.ws + OFF_U);
  bf16_t* mix = (bf16_t*)(p.ws + OFF_MIX);
  const int tid = otid(), lane = tid & 63, w = tid >> 6;
  bool lat; int sq, c, g, NC, L, rowbase; const float* S;
  if (item < 256) { lat = true; sq = item >> 6; c = (item >> 1) & 31; g = item & 1; NC = 32; L = 2048; rowbase = NCTX + sq * 2048; S = (const float*)(p.ws + OFF_SL); }
  else { int it = item - 256; lat = false; sq = it >> 3; c = (it >> 1) & 3; g = it & 1; NC = 4; L = 256; rowbase = sq * 256; S = (const float*)(p.ws + OFF_SC); }
  const int t0 = c * 64;
  ssd_load(p, l, rowbase, L, t0, g, lat, false, s);
  bf16x8 cfrag[2];
#pragma unroll
  for (int ks = 0; ks < 2; ks++) cfrag[ks] = *(const bf16x8*)(s.Cn + (16 * w + (lane & 15)) * 72 + ks * 32 + (lane >> 4) * 8);
  {
    f32x4 gacc[4];
#pragma unroll
    for (int st = 0; st < 4; st++) gacc[st] = (f32x4){0.f, 0.f, 0.f, 0.f};
#pragma unroll
    for (int ks = 0; ks < 2; ks++)
#pragma unroll
      for (int st = 0; st < 4; st++) {
        bf16x8 bb = *(const bf16x8*)(s.Bn + (16 * st + (lane & 15)) * 72 + ks * 32 + (lane >> 4) * 8);
        gacc[st] = __builtin_amdgcn_mfma_f32_16x16x32_bf16(cfrag[ks], bb, gacc[st], 0, 0, 0);
      }
#pragma unroll
    for (int st = 0; st < 4; st++)
#pragma unroll
      for (int rg = 0; rg < 4; rg++) G[(16 * w + 4 * (lane >> 4) + rg) * 68 + 16 * st + (lane & 15)] = gacc[st][rg];
  }
  __syncthreads();
  float ss[4] = {0.f, 0.f, 0.f, 0.f};
  const int lrow = 16 * w + (lane & 15);
#pragma unroll 1
  for (int h3 = 0; h3 < 3; h3++) {
    const float* csf = s.cs + h3 * 64; const float* csb = s.cs + (3 + h3) * 64;
    const float* dtf = s.dts + h3 * 64; const float* dtb = s.dts + (3 + h3) * 64;
    f32x4 acc[4];
#pragma unroll
    for (int pt = 0; pt < 4; pt++) acc[pt] = (f32x4){0.f, 0.f, 0.f, 0.f};
    const float cfl = csf[lrow], cbl = csb[lrow];
#pragma unroll
    for (int ks = 0; ks < 2; ks++) {
      const int sb = ks * 32 + (lane >> 4) * 8;
      float f[8];
#pragma unroll
      for (int e = 0; e < 8; e++) {
        int sx = sb + e;
        float gv = G[lrow * 68 + sx];
        float mf = (sx <= lrow) ? __expf(fminf(cfl - csf[sx], 0.f)) * dtf[sx] : 0.f;
        float mb = (sx >= lrow) ? __expf(fminf(cbl - csb[sx], 0.f)) * dtb[sx] : 0.f;
        f[e] = gv * (mf + mb);
      }
      bf16x8 a = as_frag(pack8(f));
#pragma unroll
      for (int pt = 0; pt < 4; pt++) {
        bf16x8 bb = *(const bf16x8*)(s.xT + (h3 * 64 + 16 * pt + (lane & 15)) * 72 + sb);
        acc[pt] = __builtin_amdgcn_mfma_f32_16x16x32_bf16(a, bb, acc[pt], 0, 0, 0);
      }
    }
#pragma unroll 1
    for (int dir = 0; dir < 2; dir++) {
      f32x4 tacc[4];
#pragma unroll
      for (int pt = 0; pt < 4; pt++) tacc[pt] = (f32x4){0.f, 0.f, 0.f, 0.f};
      const float* pv = S + (((size_t)(sq * NC + c) * 6 + 3 * g + h3) * 2 + dir) * 4096;
#pragma unroll
      for (int ks = 0; ks < 2; ks++)
#pragma unroll
        for (int pt = 0; pt < 4; pt++) {
          const float* pp = pv + (16 * pt + (lane & 15)) * 64 + ks * 32 + (lane >> 4) * 8;
          float4 a0 = *(const float4*)pp, a1 = *(const float4*)(pp + 4);
          uint4 pk;
          pk.x = pack2(a0.x, a0.y); pk.y = pack2(a0.z, a0.w); pk.z = pack2(a1.x, a1.y); pk.w = pack2(a1.z, a1.w);
          tacc[pt] = __builtin_amdgcn_mfma_f32_16x16x32_bf16(cfrag[ks], as_frag(pk), tacc[pt], 0, 0, 0);
        }
      const float* csd = dir ? csb : csf;
#pragma unroll
      for (int rg = 0; rg < 4; rg++) {
        float e = __expf(csd[16 * w + 4 * (lane >> 4) + rg]);
#pragma unroll
        for (int pt = 0; pt < 4; pt++) acc[pt][rg] += e * tacc[pt][rg];
      }
    }
    __syncthreads();
    const int hd = 3 * g + h3;
    const float Dh = p.ssd_d[l * 6 + hd];
#pragma unroll
    for (int pt = 0; pt < 4; pt++)
#pragma unroll
      for (int rg = 0; rg < 4; rg++) {
        int lr = 16 * w + 4 * (lane >> 4) + rg;
        int pch = 16 * pt + (lane & 15);
        float xv = bf2f(s.xT[(h3 * 64 + pch) * 72 + lr]);
        float yy = acc[pt][rg] + xv * Dh;
        float z = bf2f(U[(size_t)(rowbase + t0 + lr) * LDU + U_Z + hd * 64 + pch]);
        yy *= silu_f(z);
        ss[rg] += yy * yy;
        s.xT[(h3 * 64 + pch) * 72 + lr] = (bf16_t)f2bf(yy);
      }
  }
#pragma unroll
  for (int rg = 0; rg < 4; rg++) {
    float tot = grp16_sum(ss[rg]);
    float rstd = rsqrtf(tot * (1.f / 192.f) + 1e-6f);
    int lr = 16 * w + 4 * (lane >> 4) + rg;
#pragma unroll 1
    for (int h3 = 0; h3 < 3; h3++)
#pragma unroll
      for (int pt = 0; pt < 4; pt++) {
        int pch = 16 * pt + (lane & 15);
        int ch = (3 * g + h3) * 64 + pch;
        float yy = bf2f(s.xT[(h3 * 64 + pch) * 72 + lr]);
        mix[(size_t)(rowbase + t0 + lr) * 1024 + 256 + ch] = (bf16_t)f2bf(yy * rstd * p.ssd_norm[l * 384 + ch]);
      }
  }
}

__global__ void __launch_bounds__(256, 2) mega(Params p) {
  __shared__ __attribute__((aligned(16))) char smem[SMEM_BYTES];
  cg::grid_group grid = cg::this_grid();
  phase0(p, smem);
  grid.sync();
  rowpass(p, p.x_prompt, p.x_sample, false, 0, 0, nullptr, 0.f, true, 0, 0, p.norm_pre);
  grid.sync();
#pragma unroll 1
  for (int l = 0; l < 2; l++) {
    gemm_phase<0>(p, l, 0, smem);
    grid.sync();
    gemm_phase<1>(p, l, 0, smem);
    grid.sync();
    rowpass(p, l == 0 ? p.x_prompt : p.out, l == 0 ? p.x_sample : p.out + (size_t)NCTX * 1024, true, l, 2,
            p.norm_post + (l * 3 + 0) * 1024, 0.5f, true, l, 3, p.norm_pre + (l * 3 + 1) * 1024);
    grid.sync();
    gemm_phase<2>(p, l, 0, smem);
    grid.sync();
    for (int item = blockIdx.x; item < 128 + 768 + 512 + 768 + 128; item += gridDim.x) {
      if (item < 128) fourier_tile(p, item, smem);
      else if (item < 896) attn_tile(p, l, item - 128, smem);
      else if (item < 1408) ssd_state_tile(p, l, item - 896, smem);
      else if (item < 2176) attn_tile(p, l, 768 + (item - 1408), smem);
      else fourier_tile(p, 128 + (item - 2176), smem);
    }
    grid.sync();
    ssd_prefix(p, l);
    grid.sync();
    for (int item = blockIdx.x; item < 512; item += gridDim.x) ssd_out_tile(p, l, item, smem);
    grid.sync();
    gemm_phase<3>(p, l, 0, smem);
    grid.sync();
    rowpass(p, p.out, p.out + (size_t)NCTX * 1024, true, l, 5, p.norm_post + (l * 3 + 1) * 1024, 1.0f, true, l, 6,
            p.norm_pre + (l * 3 + 2) * 1024);
    grid.sync();
    gemm_phase<0>(p, l, 1, smem);
    grid.sync();
    gemm_phase<1>(p, l, 1, smem);
    grid.sync();
    rowpass(p, p.out, p.out + (size_t)NCTX * 1024, true, l, 8, p.norm_post + (l * 3 + 2) * 1024, 0.5f, l == 0, 1, 0,
            p.norm_pre + 3 * 1024);
    grid.sync();
  }
}

extern "C" void kernel_launch(void* const* d_in, const int* in_sizes, int n_in, void* d_out, int out_size, void* d_ws,
                              size_t ws_size, hipStream_t stream) {
  static int grid_blocks = 0;
  if (!grid_blocks) {
    int dev = 0, cus = 0, per_cu = 0;
    hipGetDevice(&dev);
    hipDeviceGetAttribute(&cus, hipDeviceAttributeMultiprocessorCount, dev);
    hipOccupancyMaxActiveBlocksPerMultiprocessor(&per_cu, mega, 256, 0);
    if (per_cu > 2) per_cu = 2;
    if (per_cu < 1) per_cu = 1;
    grid_blocks = cus * per_cu;
  }
  if (ws_size < WS_NEED) fprintf(stderr, "workspace too small: %zu < %zu\n", ws_size, (size_t)WS_NEED);
  Params p{};
  const float** pp = (const float**)&p;
  for (int i = 0; i < 23; i++) pp[i] = (const float*)d_in[i];
  p.out = (float*)d_out;
  p.ws = (char*)d_ws;
  void* args[] = {&p};
  hipError_t e = hipLaunchCooperativeKernel((void*)mega, dim3(grid_blocks), dim3(256), args, 0, stream);
  if (e != hipSuccess) fprintf(stderr, "cooperative launch failed: %s (grid %d)\n", hipGetErrorString(e), grid_blocks);
}
```

```cpp
#include <hip/hip_runtime.h>
#include <hip/hip_cooperative_groups.h>
#include <cstdio>
#include <cstdint>
namespace cg = cooperative_groups;

typedef unsigned short bf16_t;
typedef __attribute__((ext_vector_type(8))) short bf16x8;
typedef __attribute__((ext_vector_type(4))) float f32x4;
typedef __attribute__((ext_vector_type(16))) float f32x16;
typedef __attribute__((ext_vector_type(4))) unsigned u32x4;

constexpr int NTOK = 16384;
constexpr int NCTX = 8192;
constexpr int LDU = 2192;
constexpr int U_Z = 0, U_XBC = 384, U_DT = 1024, U_Q = 1040, U_K = 1424, U_V = 1808;
constexpr int HALF_SMEM = 68096;
constexpr int DYN_SMEM = 2 * HALF_SMEM + 32;

constexpr size_t OFF_WT13 = 0;
constexpr size_t OFF_WT2 = OFF_WT13 + (size_t)4 * 5632 * 1024 * 2;
constexpr size_t OFF_WTIN = OFF_WT2 + (size_t)4 * 1024 * 2816 * 2;
constexpr size_t OFF_WTOUT = OFF_WTIN + (size_t)2 * 2816 * 1024 * 2;
constexpr size_t OFF_MODS = OFF_WTOUT + (size_t)2 * 1024 * 1024 * 2;
constexpr size_t OFF_DFTS = OFF_MODS + (size_t)2 * 5 * 9216 * 4;
constexpr size_t OFF_DFTL = OFF_DFTS + (size_t)256 * 512 * 2;
constexpr size_t OFF_H = OFF_DFTL + (size_t)2048 * 4096 * 2;
constexpr size_t OFF_Y = OFF_H + (size_t)NTOK * 1024 * 2;
constexpr size_t OFF_P16C = OFF_Y;
constexpr size_t OFF_P16L = OFF_Y + (size_t)32 * 4 * 12 * 4096 * 2;
constexpr size_t OFF_R1 = OFF_Y + (size_t)NTOK * 1024 * 2;
constexpr size_t OFF_ACT = OFF_R1;
constexpr size_t OFF_U = OFF_R1;
constexpr size_t OFF_ABC = OFF_U + (size_t)NTOK * LDU * 2;
constexpr size_t OFF_ABL = OFF_ABC + (size_t)32 * 256 * 512 * 2;
constexpr size_t OFF_MIX = OFF_H;
constexpr size_t OFF_XB = OFF_R1 + (size_t)NTOK * 2816 * 2;
constexpr size_t OFF_SC = OFF_XB + (size_t)NTOK * 1024 * 2;
constexpr size_t OFF_SL = OFF_SC + (size_t)32 * 4 * 6 * 2 * 4096 * 4;
constexpr size_t OFF_DC = OFF_SL + (size_t)4 * 32 * 6 * 2 * 4096 * 4;
constexpr size_t OFF_DL = OFF_DC + (size_t)32 * 4 * 12 * 4;
constexpr size_t OFF_CK16 = OFF_DL + (size_t)4 * 32 * 12 * 4;
constexpr size_t OFF_CV16 = OFF_CK16 + (size_t)4 * 2 * 512 * 384 * 2;
constexpr size_t OFF_ROPE = OFF_CV16 + (size_t)4 * 2 * 512 * 384 * 2;
constexpr size_t OFF_CNT = OFF_ROPE + 8192;
constexpr size_t OFF_BAR = OFF_CNT + 1024;
constexpr size_t WS_NEED = OFF_BAR + 16384;

constexpr size_t OUT_SF = (size_t)2 * 8192 * 1024;
constexpr size_t OUT_SB = OUT_SF + (size_t)32 * 2 * 6 * 4096;
constexpr size_t OUT_CK = OUT_SB + (size_t)32 * 2 * 6 * 4096;
constexpr size_t OUT_CV = OUT_CK + (size_t)32 * 2 * 256 * 384;

struct Params {
  const float *x_prompt, *x_sample, *c, *st_f, *st_b, *ck, *cv, *c_ctx, *mod_w, *mod_b, *norm_pre, *norm_post,
      *w13, *w2, *w_in, *w_out, *conv_w, *conv_b, *dt_bias, *a_log, *ssd_d, *ssd_norm, *rpb;
  float* out;
  char* ws;
};

#if defined(__HIP_DEVICE_COMPILE__)
__device__ __forceinline__ const Params kparams() {
  auto k = __builtin_amdgcn_kernarg_segment_ptr();
  asm volatile("" : "+s"(k));
  return *(decltype((const Params __attribute__((address_space(4)))*)k))k;
}
#else
__device__ inline const Params kparams() { return Params{}; }
#endif
#ifndef PROBE_SPAN
#define PROBE_SPAN 0
#endif
#define SPAN_B(id) do { if (PROBE_SPAN == (id)) span_t0 = __builtin_amdgcn_s_memrealtime(); } while (0)
#define SPAN_E(id) do { if (PROBE_SPAN == (id)) span_acc += __builtin_amdgcn_s_memrealtime() - span_t0; } while (0)
__device__ __forceinline__ int otid4();
__device__ __forceinline__ int otid() { int t = threadIdx.x; asm volatile("" : "+v"(t)); return t; }
__device__ __forceinline__ unsigned f2bf(float f) {
  unsigned u = __float_as_uint(f);
  u += 0x7fffu + ((u >> 16) & 1u);
  return u >> 16;
}
__device__ __forceinline__ float bf2f(bf16_t h) { return __uint_as_float(((unsigned)h) << 16); }
__device__ __forceinline__ unsigned pack2(float a, float b) { return f2bf(a) | (f2bf(b) << 16); }
__device__ __forceinline__ void unpack8(uint4 r, float (&f)[8]) {
  f[0] = __uint_as_float(r.x << 16); f[1] = __uint_as_float(r.x & 0xffff0000u);
  f[2] = __uint_as_float(r.y << 16); f[3] = __uint_as_float(r.y & 0xffff0000u);
  f[4] = __uint_as_float(r.z << 16); f[5] = __uint_as_float(r.z & 0xffff0000u);
  f[6] = __uint_as_float(r.w << 16); f[7] = __uint_as_float(r.w & 0xffff0000u);
}
__device__ __forceinline__ uint4 pack8(const float (&f)[8]) {
  uint4 r;
  r.x = pack2(f[0], f[1]); r.y = pack2(f[2], f[3]); r.z = pack2(f[4], f[5]); r.w = pack2(f[6], f[7]);
  return r;
}
__device__ __forceinline__ bf16x8 as_frag(uint4 r) { return __builtin_bit_cast(bf16x8, r); }
__device__ __forceinline__ float silu_f(float x) { return x * __builtin_amdgcn_rcpf(1.f + __builtin_amdgcn_exp2f(x * -1.4426950408889634f)); }
__device__ __forceinline__ float wave_sum(float v) {
#pragma unroll
  for (int o = 32; o > 0; o >>= 1) v += __shfl_xor(v, o, 64);
  return v;
}
__device__ __forceinline__ float grp16_sum(float v) {
#pragma unroll
  for (int o = 8; o > 0; o >>= 1) v += __shfl_xor(v, o, 64);
  return v;
}
__device__ __forceinline__ float grp16_max(float v) {
#pragma unroll
  for (int o = 8; o > 0; o >>= 1) v = fmaxf(v, __shfl_xor(v, o, 64));
  return v;
}

__device__ __forceinline__ int otid4() { return otid() & 255; }
namespace pg8 {
#define PG8_LAS __attribute__((address_space(3)))
typedef unsigned short bf16_t;
typedef short bf16x8 __attribute__((ext_vector_type(8)));
typedef float f32x4 __attribute__((ext_vector_type(4)));
typedef unsigned u32x4 __attribute__((ext_vector_type(4)));
constexpr int BM = 256, BK = 64, HALF = 128, HTB = HALF * BK * 2  , STAGE_BYTES = 8 * HTB, NXCD = 8, WGM = 4;

__host__ __device__ __forceinline__ int lds_byte(int r, int c) { const int st = (r >> 4) * 2 + (c >> 5), rr = r & 15, cc = c & 31, ob = rr * 64 + cc * 2; return st * 1024 + (ob ^ (((ob >> 9) & 1) << 5)); }
__host__ __device__ __forceinline__ void stage_rc(int b, int& R, int& C) { const int st = b / 1024, sb = b % 1024, swz = sb ^ (((sb >> 9) & 1) << 5); R = (st >> 1) * 16 + swz / 64; C = (st & 1) * 32 + (swz % 64) / 2; }
__host__ __device__ __forceinline__ int perm32(int rho) { const int n = rho >> 4, i = rho & 15; return 8 * (i >> 2) + 4 * n + (i & 3); }

struct Unit { int pm, pn; };
struct Gemm { const bf16_t* A; const bf16_t* Bt; int M, N, K; };

struct StaticOrder {
    int nM, nN, nwg, G, c;
    __host__ __device__ void init(int M, int N, int G_, int c_) { nM = M / BM; nN = N / BM; nwg = nM * nN; G = G_; c = c_; }
    __host__ __device__ bool next(int i, Unit& u) const {
        const long L = (long)i * G + c; if (L >= nwg) return false;
        int wgid = (int)L; { const int q = nwg / NXCD, r = nwg % NXCD, xcd = wgid % NXCD, off = wgid / NXCD; wgid = (xcd < r ? xcd * (q + 1) : r * (q + 1) + (xcd - r) * q) + off; }
        const int nig = WGM * nN, gid = wgid / nig, fm = gid * WGM, gsz = (nM - fm) < WGM ? (nM - fm) : WGM;
        u.pm = fm + ((wgid % nig) % gsz); u.pn = (wgid % nig) / gsz; return true;
    }
    __device__ __forceinline__ void a_ready(const Unit&) const {}
    __device__ __forceinline__ void done(const Unit&) const {}
};
__device__ __forceinline__ unsigned cvt_pk_bf16(float lo, float hi) { unsigned r; asm volatile("v_cvt_pk_bf16_f32 %0, %1, %2" : "=v"(r) : "v"(lo), "v"(hi)); return r; }
template <class Epi, class Sched, bool STAMP = false>
__device__ __forceinline__ void gemm_phase(PG8_LAS unsigned char* lds, const Gemm g, const Sched& S, const Epi& E, unsigned long long* stamps) {
    const int tid = otid(), wid = __builtin_amdgcn_readfirstlane(tid >> 6), lane = tid & 63, wr = wid >> 2, wc = wid & 3, fr = lane & 15, fq = lane >> 4;
    const int K = g.K, nt = K / BK;
    int ts_lo = 0, ts_hi = 0, nts = 0; const unsigned long long rt_entry = STAMP ? (unsigned long long)wall_clock64() : 0ull;
#define PG8_STAMP() do { if (STAMP && wid == 0 && nts < 64) { const unsigned long long _c = (unsigned long long)clock64(); \
        ts_lo = (lane == nts) ? (int)(unsigned)_c : ts_lo; ts_hi = (lane == nts) ? (int)(unsigned)(_c >> 32) : ts_hi; ++nts; } } while (0)
    PG8_STAMP();
    unsigned voffA[2], voffB[2];
#pragma unroll
    for (int i = 0; i < 2; ++i) { int R, C; stage_rc(tid * 16 + i * 8192, R, C); const int Rb = Epi::PERM ? ((R & ~31) + perm32(R & 31)) : R;
        voffA[i] = (unsigned)(R * K + C) * 2u; voffB[i] = (unsigned)(Rb * K + C) * 2u; }
    const size_t kstep = (size_t)(BK * 2);
    const size_t hstep = (size_t)HALF * K * 2;
    const size_t tstep = 2 * hstep;
    const unsigned ldsw = (unsigned)wid * 1024u;
    const int aoff = lds_byte(wr * 64 + fr, fq * 8), boff = lds_byte(wc * 32 + fr, fq * 8);
#define PG8_SA(b, h) (((b) * 2 + (h)) * HTB)
#define PG8_SB(b, h) ((4 + (b) * 2 + (h)) * HTB)
#define PG8_STAGE(bufoff, gbase, voff) do { _Pragma("unroll") for (int _i = 0; _i < 2; ++_i) \
        __builtin_amdgcn_global_load_lds((const unsigned*)((const char*)(gbase) + (voff)[_i]), (PG8_LAS unsigned*)(lds + (bufoff) + ldsw + _i * 8192), 16, 0, 0); } while (0)
#define PG8_LDA(dst, b, h) do { _Pragma("unroll") for (int m = 0; m < 4; ++m) _Pragma("unroll") for (int k = 0; k < 2; ++k) dst[m][k] = *(const PG8_LAS bf16x8*)(lds + PG8_SA(b, h) + aoff + m * 2048 + k * 1024); } while (0)
#define PG8_LDB(dst, b, h) do { _Pragma("unroll") for (int n = 0; n < 2; ++n) _Pragma("unroll") for (int k = 0; k < 2; ++k) dst[n][k] = *(const PG8_LAS bf16x8*)(lds + PG8_SB(b, h) + boff + n * 2048 + k * 1024); } while (0)
#define PG8_MMA(ai, bj, At, Bt) do { __builtin_amdgcn_s_setprio(1); _Pragma("unroll") for (int m = 0; m < 4; ++m) _Pragma("unroll") for (int n = 0; n < 2; ++n) _Pragma("unroll") for (int k = 0; k < 2; ++k) \
        acc[ai][bj][m][n] = __builtin_amdgcn_mfma_f32_16x16x32_bf16(Bt[n][k], At[m][k], acc[ai][bj][m][n], 0, 0, 0); __builtin_amdgcn_s_setprio(0); } while (0)
#define PG8_WAIT_V(n) asm volatile("s_waitcnt vmcnt(" #n ")" ::: "memory")
#define PG8_WAIT_L(n) asm volatile("s_waitcnt lgkmcnt(" #n ")" ::: "memory")
#define PG8_BAR __builtin_amdgcn_s_barrier()
#define PG8_SCHED __builtin_amdgcn_sched_barrier(0)
    Unit cur, nxt; int ui = 0;
    if (!S.next(0, cur)) return;
    f32x4 acc[2][2][4][2];
#pragma unroll
    for (int a = 0; a < 2; ++a)
#pragma unroll
        for (int b = 0; b < 2; ++b)
#pragma unroll
            for (int m = 0; m < 4; ++m)
#pragma unroll
                for (int n = 0; n < 2; ++n) acc[a][b][m][n] = (f32x4){0.f, 0.f, 0.f, 0.f};
    bf16x8 At[4][2], B0[2][2], B1[2][2];
    const char* cA = (const char*)g.A + (size_t)cur.pm * tstep; const char* cB = (const char*)g.Bt + (size_t)cur.pn * tstep;
    S.a_ready(cur);
    PG8_STAGE(PG8_SB(0, 0), cB, voffB); PG8_STAGE(PG8_SA(0, 0), cA, voffA); PG8_STAGE(PG8_SB(0, 1), cB + hstep, voffB); PG8_STAGE(PG8_SA(0, 1), cA + hstep, voffA);
    if (wr == 1) PG8_BAR;
    PG8_WAIT_V(4); PG8_BAR;
    PG8_STAGE(PG8_SB(1, 0), cB + kstep, voffB); PG8_STAGE(PG8_SA(1, 0), cA + kstep, voffA); PG8_STAGE(PG8_SB(1, 1), cB + hstep + kstep, voffB);
    PG8_WAIT_V(6); PG8_BAR;
    PG8_STAMP();
    for (;;) {
        const bool has_next = S.next(ui + 1, nxt);
        const char* nA = has_next ? (const char*)g.A + (size_t)nxt.pm * tstep : cA; const char* nB = has_next ? (const char*)g.Bt + (size_t)nxt.pn * tstep : cB;
        for (int t = 0; t < nt; t += 2) {
            const bool last = (t == nt - 2);
            const char* a1 = cA + (size_t)(t + 1) * kstep;
            const char* a2 = last ? nA : cA + (size_t)(t + 2) * kstep; const char* b2 = last ? nB : cB + (size_t)(t + 2) * kstep;
            const char* a3 = a2 + kstep; const char* b3 = b2 + kstep;
            if (last && has_next) S.a_ready(nxt);
            PG8_LDB(B0, 0, 0); PG8_SCHED; PG8_LDA(At, 0, 0); PG8_STAGE(PG8_SA(1, 1), a1 + hstep, voffA);
            PG8_WAIT_L(8); PG8_BAR; PG8_WAIT_L(0); PG8_MMA(0, 0, At, B0); PG8_BAR; PG8_SCHED;
            PG8_LDB(B1, 0, 1); PG8_STAGE(PG8_SB(0, 0), b2, voffB);
            PG8_BAR; PG8_WAIT_L(0); PG8_MMA(0, 1, At, B1); PG8_BAR;
            PG8_LDA(At, 0, 1); PG8_STAGE(PG8_SA(0, 0), a2, voffA);
            PG8_BAR; PG8_WAIT_L(0); PG8_MMA(1, 0, At, B0); PG8_BAR; PG8_SCHED;
            PG8_STAGE(PG8_SB(0, 1), b2 + hstep, voffB);
            PG8_WAIT_V(6); PG8_BAR; PG8_MMA(1, 1, At, B1); PG8_BAR;
            PG8_LDB(B0, 1, 0); PG8_SCHED; PG8_LDA(At, 1, 0); PG8_STAGE(PG8_SA(0, 1), a2 + hstep, voffA);
            PG8_WAIT_L(8); PG8_BAR; PG8_WAIT_L(0); PG8_MMA(0, 0, At, B0); PG8_BAR; PG8_SCHED;
            PG8_LDB(B1, 1, 1); PG8_STAGE(PG8_SB(1, 0), b3, voffB);
            PG8_BAR; PG8_WAIT_L(0); PG8_MMA(0, 1, At, B1); PG8_BAR;
            PG8_LDA(At, 1, 1); PG8_STAGE(PG8_SA(1, 0), a3, voffA);
            PG8_BAR; PG8_WAIT_L(0); PG8_MMA(1, 0, At, B0); PG8_BAR; PG8_SCHED;
            PG8_STAGE(PG8_SB(1, 1), b3 + hstep, voffB);
            PG8_WAIT_V(6); PG8_BAR; PG8_MMA(1, 1, At, B1); PG8_BAR;
        }
        PG8_STAMP();
        if constexpr (!Epi::AFTER_DRAIN) { E(acc, cur, wr, wc, fr, fq); S.done(cur); }
        PG8_STAMP();
        if (!has_next) break;
#pragma unroll
        for (int a = 0; a < 2; ++a)
#pragma unroll
            for (int b = 0; b < 2; ++b)
#pragma unroll
                for (int m = 0; m < 4; ++m)
#pragma unroll
                    for (int n = 0; n < 2; ++n) acc[a][b][m][n] = (f32x4){0.f, 0.f, 0.f, 0.f};
        cur = nxt; cA = nA; cB = nB; ++ui;
    }
    PG8_WAIT_V(0);
    if (wr == 0) PG8_BAR;
    PG8_BAR;
    if constexpr (Epi::AFTER_DRAIN) { E.fused(acc, cur, wr, wc, fr, fq, lds, wid, lane); S.done(cur); }
    PG8_STAMP();
    if (STAMP && wid == 0) { stamps[lane] = lane < nts ? (((unsigned long long)(unsigned)ts_hi << 32) | (unsigned)ts_lo) : 0ull;
        if (lane == 62) stamps[62] = rt_entry; if (lane == 63) stamps[63] = (unsigned long long)wall_clock64(); }
#undef PG8_STAMP
#undef PG8_SA
#undef PG8_SB
#undef PG8_STAGE
#undef PG8_LDA
#undef PG8_LDB
#undef PG8_MMA
#undef PG8_WAIT_V
#undef PG8_WAIT_L
#undef PG8_BAR
#undef PG8_SCHED
}
}

__device__ __forceinline__ int map_w13(int j) {
  int pn = j >> 8, bj = (j >> 7) & 1, oc = pn * 128 + (j & 127);
  return bj ? 2816 + oc : oc;
}
__device__ __forceinline__ int map_win(int n) {
  if (n < 896) return 256 + (n - 512);
  if (n < 1536) return 640 + (n - 896);
  if (n < 1552) { int d = n - 1536; return d < 12 ? 1280 + d : -1; }
  if (n < 1936) return 1292 + (n - 1552);
  if (n < 2320) return 1676 + (n - 1936);
  if (n < 2704) return 2060 + (n - 2320);
  return -1;
}

struct XT { const float* src; bf16_t* dst; int lds, ldd, sc; float msk; };
constexpr int XP_L = 1408 + 704 + 288 + 128;
constexpr int N_XP = 2 * XP_L;
__device__ __forceinline__ XT xt_decode(const Params& p, int item, int n4) {
  XT x;
  const int l = item / XP_L, r = item % XP_L;
  int n0, k0, mapkind;
  if (r < 1408) {
    const int s = r / 704, q = r % 704;
    n0 = (q / 8) * 64; k0 = (q % 8) * 128; mapkind = 0;
    x.src = p.w13 + (size_t)(l * 2 + s) * 1024 * 5632; x.lds = 5632;
    x.dst = (bf16_t*)(p.ws + OFF_WT13) + (size_t)(l * 2 + s) * 5632 * 1024; x.ldd = 1024;
  } else if (r < 1408 + 704) {
    const int q0 = r - 1408, s = q0 / 352, q = q0 % 352;
    n0 = (q / 22) * 64; k0 = (q % 22) * 128; mapkind = 1;
    x.src = p.w2 + (size_t)(l * 2 + s) * 2816 * 1024; x.lds = 1024;
    x.dst = (bf16_t*)(p.ws + OFF_WT2) + (size_t)(l * 2 + s) * 1024 * 2816; x.ldd = 2816;
  } else if (r < 1408 + 704 + 288) {
    const int q = r - 1408 - 704;
    n0 = 512 + (q / 8) * 64; k0 = (q % 8) * 128; mapkind = 2;
    x.src = p.w_in + (size_t)l * 1024 * 2444; x.lds = 2444;
    x.dst = (bf16_t*)(p.ws + OFF_WTIN) + (size_t)l * 2816 * 1024; x.ldd = 1024;
  } else {
    const int q = r - 1408 - 704 - 288;
    n0 = (q / 8) * 64; k0 = (q % 8) * 128; mapkind = 1;
    x.src = p.w_out + (size_t)l * 1024 * 1024; x.lds = 1024;
    x.dst = (bf16_t*)(p.ws + OFF_WTOUT) + (size_t)l * 1024 * 1024; x.ldd = 1024;
  }
  const int n = n0 + n4;
  const int sc = mapkind == 0 ? map_w13(n) : (mapkind == 2 ? map_win(n) : n);
  x.sc = sc >= 0 ? sc : 0; x.msk = sc >= 0 ? 1.f : 0.f;
  x.src += (size_t)k0 * x.lds;
  x.dst += (size_t)n0 * x.ldd + k0;
  return x;
}
__device__ __forceinline__ void xt_load(const XT& x, int kk, f32x4 (&v)[8]) {
#pragma unroll
  for (int i = 0; i < 8; i++) v[i] = *(const f32x4*)(x.src + (size_t)(kk + 16 * i) * x.lds + x.sc);
}
__device__ __forceinline__ void xt_step(const Params& p, const XT& cur, bool cur_valid, int nxt_item, int tid, float* tile, f32x4 (&v)[8]) {
  const int kk = tid >> 4, n4 = (tid & 15) * 4;
  __syncthreads();
#pragma unroll
  for (int i = 0; i < 8; i++) *(f32x4*)(tile + (kk + 16 * i) * 68 + n4) = v[i] * cur.msk;
  __syncthreads();
  const XT nx = xt_decode(p, nxt_item, n4);
  xt_load(nx, kk, v);
  const int nn = tid >> 2, kq = (tid & 3) * 32;
  if (cur_valid) {
    float f[8];
#pragma unroll
    for (int hh = 0; hh < 4; hh++) {
#pragma unroll
      for (int e = 0; e < 8; e++) f[e] = tile[(kq + hh * 8 + e) * 68 + nn];
      *(uint4*)(cur.dst + (size_t)nn * cur.ldd + kq + hh * 8) = pack8(f);
    }
  }
}
__device__ __forceinline__ void xpose_all(const Params& p, float* tile) {
  const int tid = otid4(), half = otid() >> 8;
  const int kk = tid >> 4, n4 = (tid & 15) * 4;
  const int stride = gridDim.x * 2;
  const int first = blockIdx.x * 2 + half;
  const int n_it = (N_XP - blockIdx.x * 2 + stride - 1) / stride;
  f32x4 vA[8], vB[8];
  XT xa = xt_decode(p, min(first, N_XP - 1), n4);
  XT xb = xt_decode(p, min(first + stride, N_XP - 1), n4);
  xt_load(xa, kk, vA);
  xt_load(xb, kk, vB);
#pragma unroll 1
  for (int it = 0; it < n_it; it += 2) {
    const int ia = first + it * stride, ib = ia + stride;
    xt_step(p, xa, ia < N_XP, min(ia + 2 * stride, N_XP - 1), tid, tile, vA);
    xa = xt_decode(p, min(ia + 2 * stride, N_XP - 1), n4);
    xt_step(p, xb, ib < N_XP, min(ib + 2 * stride, N_XP - 1), tid, tile, vB);
    xb = xt_decode(p, min(ib + 2 * stride, N_XP - 1), n4);
  }
}

__device__ __forceinline__ void fourier_w_tile(const float* __restrict__ win, bf16_t* __restrict__ dst, int k0, int n0, float* tile) {
  const int tid = otid4(), a = tid & 63, b = tid >> 6;
  const int part = n0 >> 8, g = (n0 >> 6) & 3;
  float* trig = tile + 64 * 65;
  __syncthreads();
#pragma unroll 4
  for (int i = 0; i < 16; i++) {
    int kk = b + 4 * i;
    tile[kk * 65 + a] = win[(size_t)(k0 + kk) * 2444 + g * 64 + a];
  }
  if (tid < 64) {
    float ang = (float)tid * (6.283185307179586f / 64.f);
    trig[tid] = part ? __sinf(ang) : __cosf(ang);
  }
  __syncthreads();
  for (int i = 0; i < 16; i++) {
    int m = b + 4 * i;
    float acc = 0.f;
#pragma unroll 8
    for (int c = 0; c < 64; c++) acc += tile[a * 65 + c] * trig[(m * c) & 63];
    dst[(size_t)(n0 + m) * 1024 + k0 + a] = (bf16_t)f2bf(acc);
  }
}

__device__ __forceinline__ void mods_item(const Params& p, int item, const float* sv, float* red) {
  const int tid = otid4();
  const int l = item / 288, cgp = item % 288;
  __syncthreads();
  const int kg = tid >> 5, jj = tid & 31;
  float acc0 = 0.f, acc1 = 0.f, acc2 = 0.f, acc3 = 0.f, acc4 = 0.f;
  const float* wp = p.mod_w + (size_t)l * 1024 * 9216 + cgp * 32 + jj;
#pragma unroll 1
  for (int kb = kg * 128; kb < kg * 128 + 128; kb += 64) {
    float wv[64];
#pragma unroll
    for (int j = 0; j < 64; j++) wv[j] = wp[(size_t)(kb + j) * 9216];
#pragma unroll
    for (int j = 0; j < 64; j++) {
      const int k = kb + j;
      acc0 += sv[k] * wv[j]; acc1 += sv[1024 + k] * wv[j]; acc2 += sv[2048 + k] * wv[j]; acc3 += sv[3072 + k] * wv[j];
      acc4 += sv[4096 + k] * wv[j];
    }
  }
  red[(kg * 5 + 0) * 32 + jj] = acc0; red[(kg * 5 + 1) * 32 + jj] = acc1; red[(kg * 5 + 2) * 32 + jj] = acc2;
  red[(kg * 5 + 3) * 32 + jj] = acc3; red[(kg * 5 + 4) * 32 + jj] = acc4;
  __syncthreads();
  float* mods = (float*)(p.ws + OFF_MODS);
  if (tid < 160) {
    int v = tid >> 5, j2 = tid & 31;
    float s = 0.f;
#pragma unroll
    for (int q = 0; q < 8; q++) s += red[(q * 5 + v) * 32 + j2];
    s += p.mod_b[l * 9216 + cgp * 32 + j2];
    mods[(size_t)(l * 5 + v) * 9216 + cgp * 32 + j2] = s;
  }
}

__device__ __forceinline__ void dft_item(const Params& p, int item) {
  const int tid = otid4();
  int L, e0; bf16_t* dst;
  if (item < 64) { L = 256; e0 = item * 2048 + tid * 8; dst = (bf16_t*)(p.ws + OFF_DFTS); }
  else { L = 2048; e0 = (item - 64) * 2048 + tid * 8; dst = (bf16_t*)(p.ws + OFF_DFTL); }
  const int k = e0 / (2 * L), t0 = e0 % (2 * L);
  const float sc = rsqrtf(64.f * (float)L);
  const float w = 6.283185307179586f / (float)L;
  float f[8];
#pragma unroll
  for (int j = 0; j < 8; j++) {
    int tt = t0 + j;
    bool isin = tt >= L;
    int t = isin ? tt - L : tt;
    int r = (k * t) & (L - 1);
    float ang = (float)r * w;
    f[j] = isin ? -__sinf(ang) * sc : __cosf(ang) * sc;
  }
  *(uint4*)(dst + (size_t)e0) = pack8(f);
}

__device__ __forceinline__ void phase0(const Params& p, char* smem, unsigned long long& span_acc) {
  unsigned long long span_t0 = 0;
  const int half = otid() >> 8;
  float* tile = (float*)(smem + half * HALF_SMEM);
  if (blockIdx.x == 1) {
    for (int i = otid(); i < 1024; i += 512) {
      const int pos = i >> 4, idx = i & 15;
      const float ang = (float)pos * exp2f(-(float)idx * (13.287712379549449f / 16.f));
      ((float2*)(p.ws + OFF_ROPE))[i] = make_float2(__cosf(ang), __sinf(ang));
    }
  }
  SPAN_B(11); xpose_all(p, tile); SPAN_E(11);
  SPAN_B(12);
  constexpr int N_M = 576, N_X = 256, N_D = (64 + 4096) / 4, N_C = 1536 / 4;
  float* sv = (float*)(smem + half * HALF_SMEM + 36864);
  float* red = sv + 5 * 1024;
  for (int i = otid4(); i < 5 * 1024; i += 256) {
    int v = i >> 10, k = i & 1023;
    float x = v == 0 ? p.c_ctx[k] : p.c[(v - 1) * 1024 + k];
    sv[i] = silu_f(x);
  }
  unsigned* cnt0 = (unsigned*)(p.ws + OFF_CNT) + 224;
  volatile int* s_item = (volatile int*)(smem + 2 * HALF_SMEM);
  bool first0 = true;
  for (;;) {
    int pq;
    if (first0) { pq = (int)blockIdx.x; first0 = false; }
    else {
      __syncthreads();
      if (otid() == 0) *s_item = (int)gridDim.x + (int)atomicAdd(cnt0, 1u);
      __syncthreads();
      pq = *s_item;
    }
    const int item = pq * 2 + half;
    if (item >= N_M + N_X + N_D + N_C) break;
    if (item < N_M) {
      mods_item(p, item, sv, red);
    } else if (item < N_M + N_X) {
      const int it = item - N_M;
      const int l = it / 128, q = it % 128;
      const int nt = q / 16, kt = q % 16;
      fourier_w_tile(p.w_in + (size_t)l * 1024 * 2444, (bf16_t*)(p.ws + OFF_WTIN) + (size_t)l * 2816 * 1024, kt * 64, nt * 64, tile);
    } else if (item < N_M + N_X + N_D) {
      for (int sub = 0; sub < 4; sub++) dft_item(p, (item - N_M - N_X) * 4 + sub);
    } else {
      const int it4 = item - N_M - N_X - N_D;
      float4 a0[4], a1[4];
#pragma unroll
      for (int sub = 0; sub < 4; sub++) {
        const int it = it4 * 4 + sub;
        const float* src = it < 768 ? p.ck : p.cv;
        const size_t e0 = (size_t)(it % 768) * 2048 + (size_t)otid4() * 8;
        a0[sub] = *(const float4*)(src + e0); a1[sub] = *(const float4*)(src + e0 + 4);
      }
#pragma unroll
      for (int sub = 0; sub < 4; sub++) {
        const int it = it4 * 4 + sub;
        bf16_t* dst = (bf16_t*)(p.ws + (it < 768 ? OFF_CK16 : OFF_CV16));
        const size_t e0 = (size_t)(it % 768) * 2048 + (size_t)otid4() * 8;
        float f[8] = {a0[sub].x, a0[sub].y, a0[sub].z, a0[sub].w, a1[sub].x, a1[sub].y, a1[sub].z, a1[sub].w};
        *(uint4*)(dst + e0) = pack8(f);
      }
    }
  }
  SPAN_E(12);
}

__device__ __forceinline__ void rowpass(const Params& p, bool src_bf16, bool dst_f32, bool has_post,
                        int lpost, int gi, const float* __restrict__ gpost, float mult, bool has_pre, int lpre, int si,
                        const float* __restrict__ gpre) {
  const bf16_t* y = (const bf16_t*)(p.ws + OFF_Y);
  bf16_t* h = (bf16_t*)(p.ws + OFF_H);
  const float* mods = (const float*)(p.ws + OFF_MODS);
  const int wave = otid() >> 6, lane = otid() & 63;
  const int nw = gridDim.x * 8;
  for (int r0 = (blockIdx.x * 8 + wave) * 4; r0 < NTOK; r0 += 4 * nw) {
    float4 xv[4][4]; uint2 yr[4][4];
    float4 gpo[4], gpr[4], gt[1][4], sh4[1][4], sc4[1][4];
#pragma unroll
    for (int it = 0; it < 4; it++) {
      if (has_post) gpo[it] = *(const float4*)(gpost + it * 256 + lane * 4);
      if (has_pre) gpr[it] = *(const float4*)(gpre + it * 256 + lane * 4);
    }
#pragma unroll
    for (int q = 0; q < 4; q++) {
      const int row = r0 + q;
      const int rr = row;
      const int v = rr < NCTX ? 0 : 1 + ((rr - NCTX) >> 11);
      if (src_bf16) {
        const bf16_t* xb = (const bf16_t*)(p.ws + OFF_XB) + (size_t)rr * 1024;
#pragma unroll
        for (int it = 0; it < 4; it++) {
          uint2 raw = *(const uint2*)(xb + it * 256 + lane * 4);
          xv[q][it] = make_float4(__uint_as_float(raw.x << 16), __uint_as_float(raw.x & 0xffff0000u), __uint_as_float(raw.y << 16), __uint_as_float(raw.y & 0xffff0000u));
        }
      } else {
        const float* xr = rr < NCTX ? p.x_prompt + (size_t)rr * 1024 : p.x_sample + (size_t)(rr - NCTX) * 1024;
#pragma unroll
        for (int it = 0; it < 4; it++) { f32x4 t_ = __builtin_nontemporal_load((const f32x4*)(xr + it * 256 + lane * 4)); xv[q][it] = make_float4(t_[0], t_[1], t_[2], t_[3]); }
      }
      if (has_post) {
        const float* gm = mods + (size_t)(lpost * 5 + v) * 9216 + gi * 1024;
#pragma unroll
        for (int it = 0; it < 4; it++) {
          yr[q][it] = *(const uint2*)(y + (size_t)rr * 1024 + it * 256 + lane * 4);
          if (q == 0) gt[0][it] = *(const float4*)(gm + it * 256 + lane * 4);
        }
      }
      if (has_pre) {
        const float* sh = mods + (size_t)(lpre * 5 + v) * 9216 + si * 1024;
#pragma unroll
        for (int it = 0; it < 4; it++) {
          if (q == 0) { sh4[0][it] = *(const float4*)(sh + it * 256 + lane * 4); sc4[0][it] = *(const float4*)(sh + 1024 + it * 256 + lane * 4); }
        }
      }
    }
#pragma unroll
    for (int q = 0; q < 4; q++) {
      const int row = r0 + q;
      if (has_post) {
        float4 yv[4];
        float ss = 0.f;
#pragma unroll
        for (int it = 0; it < 4; it++) {
          uint2 raw = yr[q][it];
          yv[it].x = __uint_as_float(raw.x << 16); yv[it].y = __uint_as_float(raw.x & 0xffff0000u);
          yv[it].z = __uint_as_float(raw.y << 16); yv[it].w = __uint_as_float(raw.y & 0xffff0000u);
          ss += yv[it].x * yv[it].x + yv[it].y * yv[it].y + yv[it].z * yv[it].z + yv[it].w * yv[it].w;
        }
        ss = wave_sum(ss);
        const float r = rsqrtf(ss * (1.f / 1024.f) + 1e-6f) * mult;
#pragma unroll
        for (int it = 0; it < 4; it++) {
          const float4 g = gt[0][it], gp = gpo[it];
          xv[q][it].x += g.x * (yv[it].x * r * gp.x); xv[q][it].y += g.y * (yv[it].y * r * gp.y);
          xv[q][it].z += g.z * (yv[it].z * r * gp.z); xv[q][it].w += g.w * (yv[it].w * r * gp.w);
          if (dst_f32) { f32x4 t_ = {xv[q][it].x, xv[q][it].y, xv[q][it].z, xv[q][it].w}; __builtin_nontemporal_store(t_, (f32x4*)(p.out + (size_t)row * 1024 + it * 256 + lane * 4)); }
          else { uint2 o; o.x = pack2(xv[q][it].x, xv[q][it].y); o.y = pack2(xv[q][it].z, xv[q][it].w); *(uint2*)((bf16_t*)(p.ws + OFF_XB) + (size_t)row * 1024 + it * 256 + lane * 4) = o; }
        }
      }
      if (has_pre) {
        float ss = 0.f;
#pragma unroll
        for (int it = 0; it < 4; it++)
          ss += xv[q][it].x * xv[q][it].x + xv[q][it].y * xv[q][it].y + xv[q][it].z * xv[q][it].z + xv[q][it].w * xv[q][it].w;
        ss = wave_sum(ss);
        const float r = rsqrtf(ss * (1.f / 1024.f) + 1e-6f);
#pragma unroll
        for (int it = 0; it < 4; it++) {
          const float4 g = gpr[it], s4 = sh4[0][it], c4 = sc4[0][it];
          float h0 = xv[q][it].x * r * g.x * (1.f + c4.x) + s4.x;
          float h1 = xv[q][it].y * r * g.y * (1.f + c4.y) + s4.y;
          float h2 = xv[q][it].z * r * g.z * (1.f + c4.z) + s4.z;
          float h3 = xv[q][it].w * r * g.w * (1.f + c4.w) + s4.w;
          uint2 o; o.x = pack2(h0, h1); o.y = pack2(h2, h3);
          *(uint2*)(h + (size_t)row * 1024 + it * 256 + lane * 4) = o;
        }
      }
    }
  }
}

struct WinOrder {
  int c;
  __device__ bool next(int i, pg8::Unit& u) const {
    const int xcd = c & 7;
    if (c < 192) { if (i >= 3) return false; const int uu = i * 24 + (c >> 3); u.pm = 8 * xcd + (uu & 7); u.pn = 2 + (uu >> 3); return true; }
    if (i >= 2) return false;
    u.pm = 8 * xcd + ((c - 192) >> 3); u.pn = i; return true;
  }
  __device__ __forceinline__ void a_ready(const pg8::Unit&) const {}
  __device__ __forceinline__ void done(const pg8::Unit&) const {}
};
struct OneUnit {
  int pm, pn;
  __device__ bool next(int i, pg8::Unit& u) const { if (i) return false; u.pm = pm; u.pn = pn; return true; }
  __device__ __forceinline__ void a_ready(const pg8::Unit&) const {}
  __device__ __forceinline__ void done(const pg8::Unit&) const {}
};
__device__ __forceinline__ u32x4 pk8(const f32x4& v0, const f32x4& v1) {
  u32x4 w;
  w.x = pg8::cvt_pk_bf16(v0[0], v0[1]); w.y = pg8::cvt_pk_bf16(v0[2], v0[3]);
  w.z = pg8::cvt_pk_bf16(v1[0], v1[1]); w.w = pg8::cvt_pk_bf16(v1[2], v1[3]);
  return w;
}
struct EpiY {
  static constexpr bool PERM = true, AFTER_DRAIN = false;
  bf16_t* O; int ldc;
  __device__ __forceinline__ void operator()(const f32x4 (&acc)[2][2][4][2], const pg8::Unit& u, int wr, int wc, int fr, int fq) const {
    const int row0 = u.pm * 256 + wr * 64 + fr, col0 = u.pn * 256 + wc * 32 + 8 * fq;
#pragma unroll
    for (int ai = 0; ai < 2; ++ai)
#pragma unroll
      for (int m = 0; m < 4; ++m) {
        bf16_t* rowp = O + (size_t)(row0 + ai * 128 + m * 16) * ldc + col0;
#pragma unroll
        for (int bj = 0; bj < 2; ++bj) *(u32x4*)(rowp + bj * 128) = pk8(acc[ai][bj][m][0], acc[ai][bj][m][1]);
      }
  }
};
struct EpiSwiglu {
  static constexpr bool PERM = true, AFTER_DRAIN = false;
  bf16_t* O;
  __device__ __forceinline__ void operator()(const f32x4 (&acc)[2][2][4][2], const pg8::Unit& u, int wr, int wc, int fr, int fq) const {
    const int row0 = u.pm * 256 + wr * 64 + fr, col0 = u.pn * 128 + wc * 32 + 8 * fq;
#pragma unroll
    for (int ai = 0; ai < 2; ++ai)
#pragma unroll
      for (int m = 0; m < 4; ++m) {
        f32x4 v0, v1;
#pragma unroll
        for (int j = 0; j < 4; ++j) {
          v0[j] = silu_f(acc[ai][0][m][0][j]) * acc[ai][1][m][0][j];
          v1[j] = silu_f(acc[ai][0][m][1][j]) * acc[ai][1][m][1][j];
        }
        *(u32x4*)(O + (size_t)(row0 + ai * 128 + m * 16) * 2816 + col0) = pk8(v0, v1);
      }
  }
};
struct EpiFourier {
  static constexpr bool PERM = true, AFTER_DRAIN = false;
  bf16_t* mix; int lat;
  __device__ __forceinline__ void operator()(const f32x4 (&acc)[2][2][4][2], const pg8::Unit& u, int wr, int wc, int fr, int fq) const {
    const int row0 = (lat ? NCTX + u.pn * 2048 + u.pm * 256 : u.pn * 256) + wr * 64 + fr, col0 = wc * 32 + 8 * fq;
#pragma unroll
    for (int ai = 0; ai < 2; ++ai)
#pragma unroll
      for (int m = 0; m < 4; ++m) {
        bf16_t* rowp = mix + (size_t)(row0 + ai * 128 + m * 16) * 1024 + col0;
#pragma unroll
        for (int bj = 0; bj < 2; ++bj) *(u32x4*)(rowp + bj * 128) = pk8(acc[ai][bj][m][0], acc[ai][bj][m][1]);
      }
  }
};
struct EpiWin {
  static constexpr bool PERM = true, AFTER_DRAIN = false;
  int l;
  __device__ __forceinline__ void operator()(const f32x4 (&acc)[2][2][4][2], const pg8::Unit& u, int wr, int wc, int fr, int fq) const {
    char* ws = kparams().ws; float* out = kparams().out;
    if (u.pn < 2) {
      const int part = u.pn;
#pragma unroll
      for (int ai = 0; ai < 2; ++ai)
#pragma unroll
        for (int m = 0; m < 4; ++m) {
          int fro = fr; asm volatile("" : "+v"(fro));
          const int row = u.pm * 256 + ai * 128 + wr * 64 + m * 16 + fro;
          bf16_t* base; int L2;
          if (row < NCTX) { L2 = 512; base = (bf16_t*)(ws + OFF_ABC) + (size_t)(row >> 8) * 256 * 512 + part * 256 + (row & 255); }
          else { int mm = row - NCTX; L2 = 4096; base = (bf16_t*)(ws + OFF_ABL) + (size_t)(mm >> 11) * 256 * 4096 + part * 2048 + (mm & 2047); }
#pragma unroll
          for (int bj = 0; bj < 2; ++bj)
#pragma unroll
            for (int n = 0; n < 2; ++n)
#pragma unroll
              for (int j = 0; j < 4; ++j) {
                int nidx = bj * 128 + wc * 32 + 8 * fq + 4 * n + j;
                base[(size_t)nidx * L2] = (bf16_t)f2bf(acc[ai][bj][m][n][j]);
              }
        }
    } else {
      bf16_t* U = (bf16_t*)(ws + OFF_U);
#pragma unroll
      for (int ai = 0; ai < 2; ++ai)
#pragma unroll
        for (int m = 0; m < 4; ++m) {
          int fro = fr; asm volatile("" : "+v"(fro));
          const int row = u.pm * 256 + ai * 128 + wr * 64 + m * 16 + fro;
#pragma unroll
          for (int bj = 0; bj < 2; ++bj) {
            const int col = u.pn * 256 + bj * 128 + wc * 32 + 8 * fq;
            const int ucol = col - 512;
            if (ucol < LDU) {
              *(u32x4*)(U + (size_t)row * LDU + ucol) = pk8(acc[ai][bj][m][0], acc[ai][bj][m][1]);
              if (row < NCTX && col >= 1936) {
                const int b = row >> 8, t = row & 255;
                float* dst = (col < 2320) ? out + OUT_CK + ((size_t)((b * 2 + l) * 256 + t)) * 384 + (col - 1936)
                                          : out + OUT_CV + ((size_t)((b * 2 + l) * 256 + t)) * 384 + (col - 2320);
                *(f32x4*)dst = acc[ai][bj][m][0];
                *(f32x4*)(dst + 4) = acc[ai][bj][m][1];
              }
            }
          }
        }
    }
  }
};

template <int KIND>
__device__ __forceinline__ void gemm_phase_k(const Params& p, int l, int s, PG8_LAS unsigned char* lds) {
  pg8::Gemm g; pg8::StaticOrder S;
  if (KIND == 0) {
    g.A = (const bf16_t*)(p.ws + OFF_H); g.Bt = (const bf16_t*)(p.ws + OFF_WT13) + (size_t)(l * 2 + s) * 5632 * 1024; g.M = NTOK; g.N = 5632; g.K = 1024;
    S.init(g.M, g.N, (int)gridDim.x, (int)blockIdx.x);
    EpiSwiglu E; E.O = (bf16_t*)(p.ws + OFF_ACT);
    pg8::gemm_phase<EpiSwiglu, pg8::StaticOrder, false>(lds, g, S, E, nullptr);
  } else if (KIND == 1) {
    g.A = (const bf16_t*)(p.ws + OFF_ACT); g.Bt = (const bf16_t*)(p.ws + OFF_WT2) + (size_t)(l * 2 + s) * 1024 * 2816; g.M = NTOK; g.N = 1024; g.K = 2816;
    S.init(g.M, g.N, (int)gridDim.x, (int)blockIdx.x);
    EpiY E; E.O = (bf16_t*)(p.ws + OFF_Y); E.ldc = 1024;
    pg8::gemm_phase<EpiY, pg8::StaticOrder, false>(lds, g, S, E, nullptr);
  } else if (KIND == 2) {
    g.A = (const bf16_t*)(p.ws + OFF_H); g.Bt = (const bf16_t*)(p.ws + OFF_WTIN) + (size_t)l * 2816 * 1024; g.M = NTOK; g.N = 2816; g.K = 1024;
    EpiWin E; E.l = l;
    if (gridDim.x == 256) { WinOrder W; W.c = (int)blockIdx.x; pg8::gemm_phase<EpiWin, WinOrder, false>(lds, g, W, E, nullptr); }
    else { S.init(g.M, g.N, (int)gridDim.x, (int)blockIdx.x); pg8::gemm_phase<EpiWin, pg8::StaticOrder, false>(lds, g, S, E, nullptr); }
  } else {
    g.A = (const bf16_t*)(p.ws + OFF_MIX); g.Bt = (const bf16_t*)(p.ws + OFF_WTOUT) + (size_t)l * 1024 * 1024; g.M = NTOK; g.N = 1024; g.K = 1024;
    S.init(g.M, g.N, (int)gridDim.x, (int)blockIdx.x);
    EpiY E; E.O = (bf16_t*)(p.ws + OFF_Y); E.ldc = 1024;
    pg8::gemm_phase<EpiY, pg8::StaticOrder, false>(lds, g, S, E, nullptr);
  }
}

__device__ __forceinline__ void fourier_unit(const Params& p, int item, PG8_LAS unsigned char* lds) {
  pg8::Gemm g; OneUnit S; EpiFourier E; E.mix = (bf16_t*)(p.ws + OFF_MIX);
  if (item < 32) {
    g.A = (const bf16_t*)(p.ws + OFF_DFTL); g.Bt = (const bf16_t*)(p.ws + OFF_ABL); g.M = 2048; g.N = 1024; g.K = 4096;
    S.pm = item & 7; S.pn = item >> 3; E.lat = 1;
  } else {
    g.A = (const bf16_t*)(p.ws + OFF_DFTS); g.Bt = (const bf16_t*)(p.ws + OFF_ABC); g.M = 256; g.N = 8192; g.K = 512;
    S.pm = 0; S.pn = item - 32; E.lat = 0;
  }
  pg8::gemm_phase<EpiFourier, OneUnit, false>(lds, g, S, E, nullptr);
}

struct AttnCtx {
  const bf16_t* U; const bf16_t* CK; const bf16_t* CV;
  bf16_t* Qs; bf16_t* Ks; bf16_t* Vt; float* rp;
  int lat, l, b, h, r, rs, nch, tid, lane, w, g, ql, qc, cst, li, seg, dp, kg, vpos0, vpos1;
};

__device__ __forceinline__ void attn_load_chunk(const AttnCtx& c, int ci, u32x4 (&kr)[4], unsigned (&vr)[16]) {
#pragma unroll
  for (int kk = 0; kk < 2; kk++) {
    const bf16_t* kb; const bf16_t* vb; int ld;
    if (c.lat && ci >= 4) {
      const size_t base = ((size_t)((c.b * 2 + c.l) * 512 + (ci - 4) * 128 + kk * 64)) * 384 + c.h * 64;
      kb = c.CK + base; vb = c.CV + base; ld = 384;
    } else {
      const int krow0 = c.lat ? (NCTX + c.b * 2048 + (c.rs + 2 * ci + kk) * 64) : (c.b * 256 + ci * 128 + kk * 64);
      kb = c.U + (size_t)krow0 * LDU + U_K + c.h * 64; vb = c.U + (size_t)krow0 * LDU + U_V + c.h * 64; ld = LDU;
    }
    const bf16_t* kp = kb + (size_t)c.li * ld + c.seg;
    kr[kk * 2 + 0] = *(const u32x4*)kp; kr[kk * 2 + 1] = *(const u32x4*)(kp + 8);
    const bf16_t* vp = vb + (size_t)(c.kg * 8) * ld + 2 * c.dp;
#pragma unroll
    for (int i = 0; i < 8; i++) vr[kk * 8 + i] = *(const unsigned*)(vp + (size_t)i * ld);
  }
}

__device__ __forceinline__ void attn_step(const AttnCtx& c, int ci, u32x4 (&kr)[4], unsigned (&vr)[16], f32x4 (&oT)[4], float& mrow,
                                          float& lsum) {
  bf16_t* Qs = c.Qs; bf16_t* Ks = c.Ks; bf16_t* Vt = c.Vt;
  const int g = c.g, ql = c.ql, w = c.w;
  __syncthreads();
#pragma unroll
  for (int kk = 0; kk < 2; kk++) {
    *(u32x4*)(Ks + (kk * 64 + c.li) * 72 + c.seg) = kr[kk * 2 + 0];
    *(u32x4*)(Ks + (kk * 64 + c.li) * 72 + c.seg + 8) = kr[kk * 2 + 1];
    uint2 lo0, lo1, hi0, hi1;
    lo0.x = (vr[kk * 8 + 0] & 0xffffu) | (vr[kk * 8 + 1] << 16); lo0.y = (vr[kk * 8 + 2] & 0xffffu) | (vr[kk * 8 + 3] << 16);
    lo1.x = (vr[kk * 8 + 4] & 0xffffu) | (vr[kk * 8 + 5] << 16); lo1.y = (vr[kk * 8 + 6] & 0xffffu) | (vr[kk * 8 + 7] << 16);
    hi0.x = (vr[kk * 8 + 0] >> 16) | (vr[kk * 8 + 1] & 0xffff0000u); hi0.y = (vr[kk * 8 + 2] >> 16) | (vr[kk * 8 + 3] & 0xffff0000u);
    hi1.x = (vr[kk * 8 + 4] >> 16) | (vr[kk * 8 + 5] & 0xffff0000u); hi1.y = (vr[kk * 8 + 6] >> 16) | (vr[kk * 8 + 7] & 0xffff0000u);
    *(uint2*)(Vt + (2 * c.dp) * 136 + kk * 64 + c.vpos0) = lo0;
    *(uint2*)(Vt + (2 * c.dp) * 136 + kk * 64 + c.vpos1) = lo1;
    *(uint2*)(Vt + (2 * c.dp + 1) * 136 + kk * 64 + c.vpos0) = hi0;
    *(uint2*)(Vt + (2 * c.dp + 1) * 136 + kk * 64 + c.vpos1) = hi1;
  }
  __syncthreads();
  attn_load_chunk(c, min(ci + 2, c.nch - 1), kr, vr);
  f32x4 sT[8];
#pragma unroll
  for (int kt = 0; kt < 8; kt++) sT[kt] = (f32x4){0.f, 0.f, 0.f, 0.f};
#pragma unroll
  for (int ks = 0; ks < 2; ks++) {
    bf16x8 qb = *(const bf16x8*)(Qs + (16 * w + ql) * 72 + ks * 32 + g * 8);
#pragma unroll
    for (int kt = 0; kt < 8; kt++) {
      bf16x8 ka = *(const bf16x8*)(Ks + (16 * kt + ql) * 72 + ks * 32 + g * 8);
      sT[kt] = __builtin_amdgcn_mfma_f32_16x16x32_bf16(ka, qb, sT[kt], 0, 0, 0);
    }
  }
  if (c.lat && ci < 4) {
#pragma unroll
    for (int kt = 0; kt < 8; kt++)
#pragma unroll
      for (int rg = 0; rg < 4; rg++) {
        const int kc = 16 * (kt & 3) + 4 * g + rg;
        const int dr = c.rs + 2 * ci + (kt >> 2) - c.r + 7;
        const bool valid = (unsigned)(kc - c.cst) < 16u;
        const int dc = min(max(kc - c.qc + 15, 0), 30);
        const float biased = sT[kt][rg] + c.rp[dr * 31 + dc];
        sT[kt][rg] = valid ? biased : -1e30f;
      }
  }
  float mx = -1e30f;
#pragma unroll
  for (int kt = 0; kt < 8; kt++)
#pragma unroll
    for (int rg = 0; rg < 4; rg++) mx = fmaxf(mx, sT[kt][rg]);
  mx = fmaxf(mx, __shfl_xor(mx, 16, 64));
  mx = fmaxf(mx, __shfl_xor(mx, 32, 64));
  const float mnew = fmaxf(mrow, mx);
  const float alpha = __expf(mrow - mnew);
  float rsum = 0.f;
#pragma unroll
  for (int kt = 0; kt < 8; kt++)
#pragma unroll
    for (int rg = 0; rg < 4; rg++) {
      float pv = __expf(sT[kt][rg] - mnew);
      rsum += pv;
      sT[kt][rg] = pv;
    }
  rsum += __shfl_xor(rsum, 16, 64);
  rsum += __shfl_xor(rsum, 32, 64);
  lsum = lsum * alpha + rsum;
  mrow = mnew;
#pragma unroll
  for (int dt = 0; dt < 4; dt++) oT[dt] *= alpha;
#pragma unroll
  for (int kb = 0; kb < 4; kb++) {
    uint4 pk;
    pk.x = pack2(sT[2 * kb][0], sT[2 * kb][1]); pk.y = pack2(sT[2 * kb][2], sT[2 * kb][3]);
    pk.z = pack2(sT[2 * kb + 1][0], sT[2 * kb + 1][1]); pk.w = pack2(sT[2 * kb + 1][2], sT[2 * kb + 1][3]);
    const bf16x8 pb = as_frag(pk);
#pragma unroll
    for (int dt = 0; dt < 4; dt++) {
      bf16x8 va = *(const bf16x8*)(Vt + (16 * dt + ql) * 136 + kb * 32 + g * 8);
      oT[dt] = __builtin_amdgcn_mfma_f32_16x16x32_bf16(va, pb, oT[dt], 0, 0, 0);
    }
  }
}

__device__ __forceinline__ void attn_tile(const Params& p, int l, int item, char* smem) {
  AttnCtx c;
  c.Qs = (bf16_t*)smem;
  c.Ks = c.Qs + 64 * 72;
  c.Vt = c.Ks + 128 * 72;
  c.rp = (float*)(c.Vt + 64 * 136);
  c.U = (const bf16_t*)(p.ws + OFF_U); c.CK = (const bf16_t*)(p.ws + OFF_CK16); c.CV = (const bf16_t*)(p.ws + OFF_CV16);
  c.tid = otid4(); c.lane = c.tid & 63; c.w = c.tid >> 6; c.g = c.lane >> 4; c.ql = c.lane & 15; c.l = l;
  int rowq;
  if (item < 768) { c.lat = 1; c.b = item / 192; c.h = (item / 32) % 6; c.r = item & 31; c.rs = min(max(c.r - 4, 0), 24); rowq = NCTX + c.b * 2048 + c.r * 64; c.nch = 8; }
  else { int it = item - 768; c.lat = 0; c.b = it / 24; c.h = (it >> 2) % 6; int qb = it & 3; c.r = 0; c.rs = 0; rowq = c.b * 256 + qb * 64; c.nch = 2; }
  c.li = c.tid >> 2; c.seg = (c.tid & 3) * 16; c.dp = c.tid & 31; c.kg = c.tid >> 5;
  c.vpos0 = 32 * (c.kg >> 2) + 8 * ((2 * c.kg) & 3) + 4 * ((c.kg >> 1) & 1);
  c.vpos1 = 32 * (c.kg >> 2) + 8 * ((2 * c.kg + 1) & 3) + 4 * ((c.kg >> 1) & 1);
  c.qc = 16 * c.w + c.ql;
  c.cst = min(max(c.qc - 8, 0), 48);
  u32x4 krA[4], krB[4]; unsigned vrA[16], vrB[16];
  attn_load_chunk(c, 0, krA, vrA);
  attn_load_chunk(c, 1, krB, vrB);
  __syncthreads();
  {
    const bf16_t* qp = c.U + (size_t)(rowq + c.li) * LDU + U_Q + c.h * 64 + c.seg;
    uint4 q0 = *(const uint4*)qp, q1 = *(const uint4*)(qp + 8);
    float f[8];
    unpack8(q0, f);
#pragma unroll
    for (int e = 0; e < 8; e++) f[e] *= 0.125f;
    *(uint4*)(c.Qs + c.li * 72 + c.seg) = pack8(f);
    unpack8(q1, f);
#pragma unroll
    for (int e = 0; e < 8; e++) f[e] *= 0.125f;
    *(uint4*)(c.Qs + c.li * 72 + c.seg + 8) = pack8(f);
    if (c.lat)
      for (int i = c.tid; i < 465; i += 256) c.rp[i] = p.rpb[(size_t)(l * 6 + c.h) * 465 + i];
  }
  float mrow = -1e30f, lsum = 0.f;
  f32x4 oT[4];
#pragma unroll
  for (int i = 0; i < 4; i++) oT[i] = (f32x4){0.f, 0.f, 0.f, 0.f};
#pragma unroll 1
  for (int ci = 0; ci < c.nch; ci += 2) {
    attn_step(c, ci, krA, vrA, oT, mrow, lsum);
    attn_step(c, ci + 1, krB, vrB, oT, mrow, lsum);
  }
  bf16_t* mix = (bf16_t*)(p.ws + OFF_MIX);
  const float inv = 1.f / lsum;
  const int row = rowq + 16 * c.w + c.ql;
#pragma unroll
  for (int dt = 0; dt < 4; dt++) {
    uint2 o;
    o.x = pack2(oT[dt][0] * inv, oT[dt][1] * inv);
    o.y = pack2(oT[dt][2] * inv, oT[dt][3] * inv);
    *(uint2*)(mix + (size_t)row * 1024 + 640 + c.h * 64 + 16 * dt + 4 * c.g) = o;
  }
}

__device__ __forceinline__ void conv8(const bf16_t* __restrict__ U, const float* __restrict__ cw,
                                      const float* __restrict__ cb, int rowbase, int L, int tc, int ch, float (&o)[8]) {
  float4 b0 = *(const float4*)(cb + ch), b1 = *(const float4*)(cb + ch + 4);
  o[0] = b0.x; o[1] = b0.y; o[2] = b0.z; o[3] = b0.w; o[4] = b1.x; o[5] = b1.y; o[6] = b1.z; o[7] = b1.w;
#pragma unroll
  for (int j = 0; j < 5; j++) {
    int tt = tc + j - 2;
    if (tt >= 0 && tt < L) {
      uint4 raw = *(const uint4*)(U + (size_t)(rowbase + tt) * LDU + U_XBC + ch);
      float f[8];
      unpack8(raw, f);
      float4 w0 = *(const float4*)(cw + j * 640 + ch), w1 = *(const float4*)(cw + j * 640 + ch + 4);
      o[0] += w0.x * f[0]; o[1] += w0.y * f[1]; o[2] += w0.z * f[2]; o[3] += w0.w * f[3];
      o[4] += w1.x * f[4]; o[5] += w1.y * f[5]; o[6] += w1.z * f[6]; o[7] += w1.w * f[7];
    }
  }
#pragma unroll
  for (int e = 0; e < 8; e++) o[e] = silu_f(o[e]);
}

struct SsdSm {
  bf16_t* xT;
  bf16_t* Bn;
  bf16_t* Cn;
  bf16_t* BT;
  float* dts;
  float* cs;
  float* wts;
  float* G;
};
__device__ __forceinline__ SsdSm ssd_carve(char* smem) {
  SsdSm s;
  s.xT = (bf16_t*)smem;
  s.Bn = s.xT + 192 * 72;
  s.Cn = s.Bn + 64 * 72;
  s.dts = (float*)(s.Cn + 64 * 72);
  s.cs = s.dts + 384;
  s.wts = s.cs + 384;
  s.BT = (bf16_t*)(s.wts + 384);
  s.G = s.wts + 384;
  return s;
}

__device__ __forceinline__ u32x4 ld_row(const bf16_t* __restrict__ U, int rowbase, int L, int tt, int chcol) {
  const int tc = min(max(tt, 0), L - 1);
  return *(const u32x4*)(U + (size_t)(rowbase + tc) * LDU + U_XBC + chcol);
}
__device__ __forceinline__ void unpack8v(u32x4 r, float m, float (&f)[8]) {
  f[0] = __uint_as_float(r.x << 16) * m; f[1] = __uint_as_float(r.x & 0xffff0000u) * m;
  f[2] = __uint_as_float(r.y << 16) * m; f[3] = __uint_as_float(r.y & 0xffff0000u) * m;
  f[4] = __uint_as_float(r.z << 16) * m; f[5] = __uint_as_float(r.z & 0xffff0000u) * m;
  f[6] = __uint_as_float(r.w << 16) * m; f[7] = __uint_as_float(r.w & 0xffff0000u) * m;
}
template <int NT>
__device__ __forceinline__ void conv_block(const bf16_t* __restrict__ U, const float* __restrict__ cw, const float* __restrict__ cb,
                                           int rowbase, int L, int tfirst, int ch, float (&o)[NT][8]) {
  u32x4 raw[NT + 4];
#pragma unroll
  for (int i = 0; i < NT + 4; i++) raw[i] = ld_row(U, rowbase, L, tfirst + i - 2, ch);
  float4 w0[5], w1[5];
#pragma unroll
  for (int j = 0; j < 5; j++) { w0[j] = *(const float4*)(cw + j * 640 + ch); w1[j] = *(const float4*)(cw + j * 640 + ch + 4); }
  const float4 b0 = *(const float4*)(cb + ch), b1 = *(const float4*)(cb + ch + 4);
#pragma unroll
  for (int i = 0; i < NT; i++) { o[i][0] = b0.x; o[i][1] = b0.y; o[i][2] = b0.z; o[i][3] = b0.w; o[i][4] = b1.x; o[i][5] = b1.y; o[i][6] = b1.z; o[i][7] = b1.w; }
#pragma unroll
  for (int rI = 0; rI < NT + 4; rI++) {
    const int tt = tfirst + rI - 2;
    const float m = (tt >= 0 && tt < L) ? 1.f : 0.f;
    float f[8];
    unpack8v(raw[rI], m, f);
#pragma unroll
    for (int j = 0; j < 5; j++) {
      const int i = rI - j;
      if (i >= 0 && i < NT) {
        o[i][0] += w0[j].x * f[0]; o[i][1] += w0[j].y * f[1]; o[i][2] += w0[j].z * f[2]; o[i][3] += w0[j].w * f[3];
        o[i][4] += w1[j].x * f[4]; o[i][5] += w1[j].y * f[5]; o[i][6] += w1[j].z * f[6]; o[i][7] += w1[j].w * f[7];
      }
    }
  }
#pragma unroll
  for (int i = 0; i < NT; i++)
#pragma unroll
    for (int e = 0; e < 8; e++) o[i][e] = silu_f(o[i][e]);
}

__device__ __forceinline__ void ssd_load(const Params& p, int l, int rowbase, int L, int t0, int g, bool rope, bool needBT,
                         const SsdSm& s) {
  const bf16_t* U = (const bf16_t*)(p.ws + OFF_U);
  const float* cw = p.conv_w + (size_t)l * 5 * 640;
  const float* cb = p.conv_b + (size_t)l * 640;
  const int tid = otid4(), lane = tid & 63, w = tid >> 6;
  __syncthreads();
#pragma unroll 1
  for (int rnd = 0; rnd < 2; rnd++) {
    const int unit = rnd * 256 + tid;
    if (unit < 384) {
      const int cbk = unit % 24, tg = unit / 24;
      float o[4][8];
      conv_block<4>(U, cw, cb, rowbase, L, t0 + 4 * tg, 192 * g + cbk * 8, o);
#pragma unroll
      for (int e = 0; e < 8; e++) {
        uint2 pk;
        pk.x = pack2(o[0][e], o[1][e]); pk.y = pack2(o[2][e], o[3][e]);
        *(uint2*)(s.xT + (cbk * 8 + e) * 72 + 4 * tg) = pk;
      }
    } else {
      const int t128 = unit - 384;
      float raw[3];
#pragma unroll
      for (int k = 0; k < 3; k++) {
        const int i = t128 + 128 * k, t = i / 6, hh = i % 6;
        const int dir = hh / 3, h3 = hh % 3, hd = 3 * g + h3;
        raw[k] = bf2f(U[(size_t)(rowbase + t0 + t) * LDU + U_DT + dir * 6 + hd]) + p.dt_bias[(l * 2 + dir) * 6 + hd];
      }
#pragma unroll
      for (int k = 0; k < 3; k++) {
        const int i = t128 + 128 * k, t = i / 6, hh = i % 6;
        const int dir = hh / 3, h3 = hh % 3;
        s.dts[(dir * 3 + h3) * 64 + t] = raw[k] > 20.f ? raw[k] : log1pf(__expf(raw[k]));
      }
    }
  }
  {
    const int t2 = tid >> 3, which = (tid >> 2) & 1, pb = tid & 3;
    const int q = (pb & 1) * 8 + (pb >> 1) * 32;
    const int chb = 384 + which * 128 + g * 64;
    bf16_t* arr = which ? s.Cn : s.Bn;
    int two = 2;
    asm volatile("" : "+s"(two));
#pragma unroll 1
    for (int hv = 0; hv < two; hv++) {
      float o[2][8];
      conv_block<2>(U, cw, cb, rowbase, L, t0 + 2 * t2, chb + q + 16 * hv, o);
      *(uint4*)(arr + (2 * t2) * 72 + q + 16 * hv) = pack8(o[0]);
      *(uint4*)(arr + (2 * t2 + 1) * 72 + q + 16 * hv) = pack8(o[1]);
    }
    if (rope || (which == 0 && needBT)) {
#pragma unroll 1
      for (int i = 0; i < two; i++) {
        const int t = 2 * t2 + i;
        float v1[8], v2[8];
        unpack8(*(const uint4*)(arr + t * 72 + q), v1);
        unpack8(*(const uint4*)(arr + t * 72 + q + 16), v2);
        if (rope) {
          const int tabs = t0 + t;
          const int pos = (q < 32) ? (tabs >> 6) : (tabs & 63);
          const float4* rt = (const float4*)(p.ws + OFF_ROPE) + (pos * 16 + (q & 15)) / 2;
          const float4 r0 = rt[0], r1 = rt[1], r2 = rt[2], r3 = rt[3];
          const float cs_[8] = {r0.x, r0.z, r1.x, r1.z, r2.x, r2.z, r3.x, r3.z};
          const float sn_[8] = {r0.y, r0.w, r1.y, r1.w, r2.y, r2.w, r3.y, r3.w};
#pragma unroll
          for (int e = 0; e < 8; e++) {
            const float a = v1[e], bb = v2[e];
            v1[e] = a * cs_[e] - bb * sn_[e];
            v2[e] = a * sn_[e] + bb * cs_[e];
          }
          *(uint4*)(arr + t * 72 + q) = pack8(v1);
          *(uint4*)(arr + t * 72 + q + 16) = pack8(v2);
        }
        if (which == 0 && needBT) {
#pragma unroll
          for (int e = 0; e < 8; e++) {
            s.BT[(q + e) * 72 + t] = (bf16_t)f2bf(v1[e]);
            s.BT[(q + 16 + e) * 72 + t] = (bf16_t)f2bf(v2[e]);
          }
        }
      }
    }
  }
  __syncthreads();
  for (int sq = w; sq < 6; sq += 4) {
    int dir = sq / 3, h3 = sq % 3;
    float a = -__expf(p.a_log[(l * 2 + dir) * 6 + 3 * g + h3]);
    int t = dir ? 63 - lane : lane;
    float v = s.dts[sq * 64 + t] * a;
#pragma unroll
    for (int o = 1; o < 64; o <<= 1) {
      float n = __shfl_up(v, o, 64);
      if (lane >= o) v += n;
    }
    s.cs[sq * 64 + t] = v;
  }
  __syncthreads();
}

__device__ __forceinline__ void ssd_state_tile(const Params& p, int l, int item, char* smem) {
  SsdSm s = ssd_carve(smem);
  const int tid = otid4(), lane = tid & 63, w = tid >> 6;
  bool lat; int sq, c, g, NC, L, rowbase; float* S; float* dec;
  if (item < 256) { lat = true; sq = item >> 6; c = (item >> 1) & 31; g = item & 1; NC = 32; L = 2048; rowbase = NCTX + sq * 2048; S = (float*)(p.ws + OFF_SL); dec = (float*)(p.ws + OFF_DL); }
  else { int it = item - 256; lat = false; sq = it >> 3; c = (it >> 1) & 3; g = it & 1; NC = 4; L = 256; rowbase = sq * 256; S = (float*)(p.ws + OFF_SC); dec = (float*)(p.ws + OFF_DC); }
  ssd_load(p, l, rowbase, L, c * 64, g, lat, true, s);
  for (int i = tid; i < 384; i += 256) {
    int q = i >> 6, t = i & 63;
    int dir = q / 3;
    float ce = dir ? s.cs[q * 64 + 0] : s.cs[q * 64 + 63];
    s.wts[i] = __expf(ce - s.cs[i]) * s.dts[i];
  }
  __syncthreads();
#pragma unroll 1
  for (int q = 0; q < 6; q++) {
    const int dir = q / 3, h3 = q % 3;
    f32x4 acc[4];
#pragma unroll
    for (int nt = 0; nt < 4; nt++) acc[nt] = (f32x4){0.f, 0.f, 0.f, 0.f};
#pragma unroll
    for (int ks = 0; ks < 2; ks++) {
      const int tb = ks * 32 + (lane >> 4) * 8;
      uint4 raw = *(const uint4*)(s.xT + (h3 * 64 + 16 * w + (lane & 15)) * 72 + tb);
      float f[8];
      unpack8(raw, f);
#pragma unroll
      for (int e = 0; e < 8; e++) f[e] *= s.wts[q * 64 + tb + e];
      bf16x8 a = as_frag(pack8(f));
#pragma unroll
      for (int nt = 0; nt < 4; nt++) {
        bf16x8 bb = *(const bf16x8*)(s.BT + (16 * nt + (lane & 15)) * 72 + tb);
        acc[nt] = __builtin_amdgcn_mfma_f32_16x16x32_bf16(bb, a, acc[nt], 0, 0, 0);
      }
    }
    const size_t idx = ((size_t)(sq * NC + c) * 6 + 3 * g + h3) * 2 + dir;
    bf16_t* So = (bf16_t*)S + idx * 4096;
#pragma unroll
    for (int nt = 0; nt < 4; nt++) {
      uint2 o; o.x = pack2(acc[nt][0], acc[nt][1]); o.y = pack2(acc[nt][2], acc[nt][3]);
      *(uint2*)(So + (16 * w + (lane & 15)) * 64 + 16 * nt + 4 * (lane >> 4)) = o;
    }
    if (tid == 0) dec[idx] = __expf(dir ? s.cs[q * 64 + 0] : s.cs[q * 64 + 63]);
  }
}

__device__ __forceinline__ void ssd_prefix(const Params& p, int l) {
  const int gt = blockIdx.x * 512 + otid(), nthr = gridDim.x * 512;
  {
    const bf16_t* S = (const bf16_t*)(p.ws + OFF_SC);
    bf16_t* P16 = (bf16_t*)(p.ws + OFF_P16C);
    const float* dec = (const float*)(p.ws + OFF_DC);
    const int total = 32 * 12 * 4096;
    for (int e0 = gt; e0 < total; e0 += 12 * nthr) {
      float sv[12][4], dv[12][4];
#pragma unroll
      for (int j = 0; j < 12; j++) {
        const int e = min(e0 + j * nthr, total - 1);
        const int pn = e & 4095, r = e >> 12, dir = r & 1, h = (r >> 1) % 6, sq = r / 12;
#pragma unroll
        for (int ci = 0; ci < 4; ci++) {
          const int c = dir ? 3 - ci : ci;
          const size_t ix = ((size_t)(sq * 4 + c) * 6 + h) * 2 + dir;
          sv[j][ci] = bf2f(S[ix * 4096 + pn]);
          dv[j][ci] = dec[ix];
        }
      }
#pragma unroll
      for (int j = 0; j < 12; j++) {
        const int e = e0 + j * nthr;
        if (e < total) {
          const int pn = e & 4095, r = e >> 12, dir = r & 1, h = (r >> 1) % 6, sq = r / 12;
          float run = 0.f;
#pragma unroll
          for (int ci = 0; ci < 4; ci++) {
            const int c = dir ? 3 - ci : ci;
            const size_t ix = ((size_t)(sq * 4 + c) * 6 + h) * 2 + dir;
            P16[ix * 4096 + pn] = (bf16_t)f2bf(run);
            run = run * dv[j][ci] + sv[j][ci];
          }
          p.out[(dir ? OUT_SB : OUT_SF) + ((size_t)(sq * 2 + l) * 6 + h) * 4096 + pn] = run;
        }
      }
    }
  }
  {
    const bf16_t* S = (const bf16_t*)(p.ws + OFF_SL);
    bf16_t* P16 = (bf16_t*)(p.ws + OFF_P16L);
    const float* dec = (const float*)(p.ws + OFF_DL);
    const int total = 4 * 12 * 4096;
    for (int e = gt; e < total; e += nthr) {
      const int pn = e & 4095, r = e >> 12, dir = r & 1, h = (r >> 1) % 6, sq = r / 12;
      float run = (dir ? p.st_b : p.st_f)[((size_t)(sq * 2 + l) * 6 + h) * 4096 + pn];
      float sv[32], dv[32];
#pragma unroll
      for (int ci = 0; ci < 32; ci++) {
        const int c = dir ? 31 - ci : ci;
        const size_t ix = ((size_t)(sq * 32 + c) * 6 + h) * 2 + dir;
        sv[ci] = bf2f(S[ix * 4096 + pn]);
        dv[ci] = dec[ix];
      }
#pragma unroll
      for (int ci = 0; ci < 32; ci++) {
        const int c = dir ? 31 - ci : ci;
        const size_t ix = ((size_t)(sq * 32 + c) * 6 + h) * 2 + dir;
        P16[ix * 4096 + pn] = (bf16_t)f2bf(run);
        run = run * dv[ci] + sv[ci];
      }
    }
  }
}

__device__ __forceinline__ void ssd_ld_prev(const bf16_t* __restrict__ P16, size_t idx, int lane, u32x4 (&pf)[8]) {
  const bf16_t* pv = P16 + idx * 4096;
#pragma unroll
  for (int ks = 0; ks < 2; ks++)
#pragma unroll
    for (int pt = 0; pt < 4; pt++) pf[ks * 4 + pt] = *(const u32x4*)(pv + (16 * pt + (lane & 15)) * 64 + ks * 32 + (lane >> 4) * 8);
}

__device__ __forceinline__ void ssd_out_tile(const Params& p, int l, int item, char* smem) {
  SsdSm s = ssd_carve(smem);
  float* G = s.G;
  const bf16_t* U = (const bf16_t*)(p.ws + OFF_U);
  bf16_t* mix = (bf16_t*)(p.ws + OFF_MIX);
  const int tid = otid4(), lane = tid & 63, w = tid >> 6;
  bool lat; int sq, c, g, NC, L, rowbase; const bf16_t* P16;
  if (item < 256) { lat = true; sq = item >> 6; c = (item >> 1) & 31; g = item & 1; NC = 32; L = 2048; rowbase = NCTX + sq * 2048; P16 = (const bf16_t*)(p.ws + OFF_P16L); }
  else { int it = item - 256; lat = false; sq = it >> 3; c = (it >> 1) & 3; g = it & 1; NC = 4; L = 256; rowbase = sq * 256; P16 = (const bf16_t*)(p.ws + OFF_P16C); }
  const int t0 = c * 64;
  const size_t idx0 = ((size_t)(sq * NC + c) * 6 + 3 * g) * 2;
  ssd_load(p, l, rowbase, L, t0, g, lat, false, s);
  u32x4 pfA[8], pfB[8];
  ssd_ld_prev(P16, idx0 + 0, lane, pfA);
  ssd_ld_prev(P16, idx0 + 1, lane, pfB);
  bf16x8 cfrag[2];
#pragma unroll
  for (int ks = 0; ks < 2; ks++) cfrag[ks] = *(const bf16x8*)(s.Cn + (16 * w + (lane & 15)) * 72 + ks * 32 + (lane >> 4) * 8);
  {
    f32x4 gacc[4];
#pragma unroll
    for (int st = 0; st < 4; st++) gacc[st] = (f32x4){0.f, 0.f, 0.f, 0.f};
#pragma unroll
    for (int ks = 0; ks < 2; ks++)
#pragma unroll
      for (int st = 0; st < 4; st++) {
        bf16x8 bb = *(const bf16x8*)(s.Bn + (16 * st + (lane & 15)) * 72 + ks * 32 + (lane >> 4) * 8);
        gacc[st] = __builtin_amdgcn_mfma_f32_16x16x32_bf16(cfrag[ks], bb, gacc[st], 0, 0, 0);
      }
#pragma unroll
    for (int st = 0; st < 4; st++)
#pragma unroll
      for (int rg = 0; rg < 4; rg++) G[(16 * w + 4 * (lane >> 4) + rg) * 68 + 16 * st + (lane & 15)] = gacc[st][rg];
  }
  __syncthreads();
  float ss[4] = {0.f, 0.f, 0.f, 0.f};
  const int lrow = 16 * w + (lane & 15);
#pragma unroll
  for (int h3 = 0; h3 < 3; h3++) {
    const float* csf = s.cs + h3 * 64; const float* csb = s.cs + (3 + h3) * 64;
    const float* dtf = s.dts + h3 * 64; const float* dtb = s.dts + (3 + h3) * 64;
    f32x4 acc[4];
#pragma unroll
    for (int pt = 0; pt < 4; pt++) acc[pt] = (f32x4){0.f, 0.f, 0.f, 0.f};
    bf16_t zr[16];
#pragma unroll
    for (int pt = 0; pt < 4; pt++)
#pragma unroll
      for (int rg = 0; rg < 4; rg++)
        zr[pt * 4 + rg] = U[(size_t)(rowbase + t0 + 16 * w + 4 * (lane >> 4) + rg) * LDU + U_Z + (3 * g + h3) * 64 + 16 * pt + (lane & 15)];
    const float cfl = csf[lrow], cbl = csb[lrow];
#pragma unroll
    for (int ks = 0; ks < 2; ks++) {
      const int sb = ks * 32 + (lane >> 4) * 8;
      float f[8];
#pragma unroll
      for (int e = 0; e < 8; e++) {
        int sx = sb + e;
        float gv = G[lrow * 68 + sx];
        float mf = (sx <= lrow) ? __expf(fminf(cfl - csf[sx], 0.f)) * dtf[sx] : 0.f;
        float mb = (sx >= lrow) ? __expf(fminf(cbl - csb[sx], 0.f)) * dtb[sx] : 0.f;
        f[e] = gv * (mf + mb);
      }
      bf16x8 a = as_frag(pack8(f));
#pragma unroll
      for (int pt = 0; pt < 4; pt++) {
        bf16x8 bb = *(const bf16x8*)(s.xT + (h3 * 64 + 16 * pt + (lane & 15)) * 72 + sb);
        acc[pt] = __builtin_amdgcn_mfma_f32_16x16x32_bf16(a, bb, acc[pt], 0, 0, 0);
      }
    }
    const size_t idxn = idx0 + (size_t)(h3 < 2 ? h3 + 1 : 2) * 2;
    {
      f32x4 tacc[4];
#pragma unroll
      for (int pt = 0; pt < 4; pt++) tacc[pt] = (f32x4){0.f, 0.f, 0.f, 0.f};
#pragma unroll
      for (int ks = 0; ks < 2; ks++)
#pragma unroll
        for (int pt = 0; pt < 4; pt++)
          tacc[pt] = __builtin_amdgcn_mfma_f32_16x16x32_bf16(cfrag[ks], __builtin_bit_cast(bf16x8, pfA[ks * 4 + pt]), tacc[pt], 0, 0, 0);
      ssd_ld_prev(P16, idxn + 0, lane, pfA);
#pragma unroll
      for (int rg = 0; rg < 4; rg++) {
        float e = __expf(csf[16 * w + 4 * (lane >> 4) + rg]);
#pragma unroll
        for (int pt = 0; pt < 4; pt++) acc[pt][rg] += e * tacc[pt][rg];
      }
    }
    {
      f32x4 tacc[4];
#pragma unroll
      for (int pt = 0; pt < 4; pt++) tacc[pt] = (f32x4){0.f, 0.f, 0.f, 0.f};
#pragma unroll
      for (int ks = 0; ks < 2; ks++)
#pragma unroll
        for (int pt = 0; pt < 4; pt++)
          tacc[pt] = __builtin_amdgcn_mfma_f32_16x16x32_bf16(cfrag[ks], __builtin_bit_cast(bf16x8, pfB[ks * 4 + pt]), tacc[pt], 0, 0, 0);
      ssd_ld_prev(P16, idxn + 1, lane, pfB);
#pragma unroll
      for (int rg = 0; rg < 4; rg++) {
        float e = __expf(csb[16 * w + 4 * (lane >> 4) + rg]);
#pragma unroll
        for (int pt = 0; pt < 4; pt++) acc[pt][rg] += e * tacc[pt][rg];
      }
    }
    __syncthreads();
    const int hd = 3 * g + h3;
    const float Dh = p.ssd_d[l * 6 + hd];
#pragma unroll
    for (int pt = 0; pt < 4; pt++)
#pragma unroll
      for (int rg = 0; rg < 4; rg++) {
        int lr = 16 * w + 4 * (lane >> 4) + rg;
        int pch = 16 * pt + (lane & 15);
        float xv = bf2f(s.xT[(h3 * 64 + pch) * 72 + lr]);
        float yy = acc[pt][rg] + xv * Dh;
        float z = bf2f(zr[pt * 4 + rg]);
        yy *= silu_f(z);
        ss[rg] += yy * yy;
        s.xT[(h3 * 64 + pch) * 72 + lr] = (bf16_t)f2bf(yy);
      }
  }
  float nwt[3][4];
#pragma unroll
  for (int h3 = 0; h3 < 3; h3++)
#pragma unroll
    for (int pt = 0; pt < 4; pt++) nwt[h3][pt] = p.ssd_norm[l * 384 + (3 * g + h3) * 64 + 16 * pt + (lane & 15)];
#pragma unroll
  for (int rg = 0; rg < 4; rg++) {
    float tot = grp16_sum(ss[rg]);
    float rstd = rsqrtf(tot * (1.f / 192.f) + 1e-6f);
    int lr = 16 * w + 4 * (lane >> 4) + rg;
#pragma unroll
    for (int h3 = 0; h3 < 3; h3++)
#pragma unroll
      for (int pt = 0; pt < 4; pt++) {
        int pch = 16 * pt + (lane & 15);
        int ch = (3 * g + h3) * 64 + pch;
        float yy = bf2f(s.xT[(h3 * 64 + pch) * 72 + lr]);
        mix[(size_t)(rowbase + t0 + lr) * 1024 + 256 + ch] = (bf16_t)f2bf(yy * rstd * nwt[h3][pt]);
      }
  }
}

#define XB_TMO      128
#define XB_XCNT(j)  (256  + 64 * (j))
#define XB_XSUB(j)  (1280 + 64 * (j))
#define XB_XGEN(j)  (2304 + 64 * (j))
#define XB_TOP      3328
#define XB_TOPGEN   3392
#define XCD_BAR_WORDS 3456
#define XB_SPIN_CAP (1u << 18)
#define LAS __attribute__((address_space(3)))

__device__ __forceinline__ unsigned xb_ld(unsigned* p)              { return __hip_atomic_load(p, __ATOMIC_RELAXED, __HIP_MEMORY_SCOPE_AGENT); }
__device__ __forceinline__ unsigned xb_add(unsigned* p, unsigned v) { return __hip_atomic_fetch_add(p, v, __ATOMIC_RELAXED, __HIP_MEMORY_SCOPE_AGENT); }
__device__ __forceinline__ unsigned xb_xcc_id() { return (unsigned)__builtin_amdgcn_s_getreg((3 << 11) | 20) & 0xFu; }
#define XB_SPIN(cond, bar) do { unsigned _sp = 0; while (cond) { __builtin_amdgcn_s_sleep(1); \
    if ((++_sp & 255u) == 0u) { if (xb_ld(&(bar)[XB_TMO])) break; if (_sp > XB_SPIN_CAP) { atomicAdd(&(bar)[XB_TMO], 1u); break; } } } } while (0)

struct XcdBarrier {
    unsigned* bar; unsigned x;
    volatile LAS unsigned* st;
};

__device__ __forceinline__ XcdBarrier xcd_barrier_post(unsigned* bar, volatile LAS unsigned* st) {
    XcdBarrier b; b.bar = bar; b.x = xb_xcc_id(); b.st = st;
    if (otid() == 0) (void)xb_add(&bar[XB_XCNT(b.x)], 1u);
    return b;
}
__device__ __forceinline__ void xcd_barrier_complete(unsigned* bar, unsigned x, unsigned& nloc, unsigned& nx) {
    const unsigned G = gridDim.x * gridDim.y * gridDim.z;
    unsigned sum, cnt, mine, sp = 0u;
    for (;;) {
        sum = 0u; cnt = 0u; mine = 0u;
#pragma unroll
        for (unsigned j = 0; j < 16; ++j) { const unsigned c = xb_ld(&bar[XB_XCNT(j)]); sum += c; cnt += (c > 0u) ? 1u : 0u; mine = (j == x) ? c : mine; }
        if (sum == G) break;
        __builtin_amdgcn_s_sleep(1);
        if ((++sp & 255u) == 0u) { if (xb_ld(&bar[XB_TMO])) break; if (sp > XB_SPIN_CAP) { atomicAdd(&bar[XB_TMO], 1u); break; } }
    }
    nloc = mine > 0u ? mine : 1u; nx = cnt > 0u ? cnt : 1u;
}

__device__ __forceinline__ void xcd_barrier(const XcdBarrier& b) {
    asm volatile("s_waitcnt vmcnt(0)" ::: "memory");
    __syncthreads();
    if (otid() == 0) {
        unsigned* bar = b.bar;
        __builtin_amdgcn_s_waitcnt(0);
        unsigned nloc = b.st[0], nx = b.st[1];
        if (nloc == 0u) { xcd_barrier_complete(bar, b.x, nloc, nx); b.st[0] = nloc; b.st[1] = nx; }
        const unsigned old = xb_add(&bar[XB_XSUB(b.x)], 1u);
        const unsigned gen = old / nloc;
        if (old + 1u == (gen + 1u) * nloc) {
            __builtin_amdgcn_fence(__ATOMIC_RELEASE, "agent");
            asm volatile("s_waitcnt vmcnt(0)" ::: "memory");
            const unsigned og = xb_add(&bar[XB_TOP], 1u);
            const unsigned tg = og / nx;
            if (og + 1u == (tg + 1u) * nx) xb_add(&bar[XB_TOPGEN], 1u);
            else XB_SPIN(xb_ld(&bar[XB_TOPGEN]) == tg, bar);
            __builtin_amdgcn_fence(__ATOMIC_ACQUIRE, "agent");
            xb_add(&bar[XB_XGEN(b.x)], 1u);
            asm volatile("s_waitcnt vmcnt(0)" ::: "memory");
        } else {
            XB_SPIN(xb_ld(&bar[XB_XGEN(b.x)]) == gen, bar);
            __builtin_amdgcn_fence(__ATOMIC_ACQUIRE, "agent");
            asm volatile("s_waitcnt vmcnt(0)" ::: "memory");
        }
    }
    __syncthreads();
}

__device__ __forceinline__ void gsync(unsigned* ctr, unsigned& nb) {
  asm volatile("s_waitcnt vmcnt(0) lgkmcnt(0)" ::: "memory");
  __syncthreads();
  nb += gridDim.x;
  if (threadIdx.x == 0) {
    __builtin_amdgcn_fence(__ATOMIC_RELEASE, "agent");
    asm volatile("s_waitcnt vmcnt(0)" ::: "memory");
    __hip_atomic_fetch_add(ctr, 1u, __ATOMIC_RELAXED, __HIP_MEMORY_SCOPE_AGENT);
    while (__hip_atomic_load(ctr, __ATOMIC_RELAXED, __HIP_MEMORY_SCOPE_AGENT) < nb) __builtin_amdgcn_s_sleep(2);
    __builtin_amdgcn_fence(__ATOMIC_ACQUIRE, "agent");
    asm volatile("s_waitcnt vmcnt(0)" ::: "memory");
  }
  __syncthreads();
}

#ifndef REP_FL
#define REP_FL 1
#endif
#ifndef REP_SS
#define REP_SS 1
#endif
#ifndef REP_AL
#define REP_AL 1
#endif
#ifndef REP_AC
#define REP_AC 1
#endif
#ifndef REP_PF
#define REP_PF 1
#endif
#ifndef REP_G
#define REP_G 1
#endif
#ifndef REP_MA
#define REP_MA 1
#endif
#ifndef REP_SO
#define REP_SO 1
#endif
#ifndef REP_P0
#define REP_P0 1
#endif
template <int l>
__device__ __forceinline__ void layer_body(const XcdBarrier& xb, char* smem, PG8_LAS unsigned char* lds, unsigned long long& span_acc) {
  unsigned long long span_t0 = 0;
    for (int rep = 0; rep < REP_G; rep++) { SPAN_B(2); gemm_phase_k<0>(kparams(), l, 0, lds); SPAN_E(2); SPAN_B(1); xcd_barrier(xb); SPAN_E(1); }
    for (int rep = 0; rep < REP_G; rep++) { SPAN_B(3); gemm_phase_k<1>(kparams(), l, 0, lds); SPAN_E(3); SPAN_B(1); xcd_barrier(xb); SPAN_E(1); }
    SPAN_B(6);
    rowpass(kparams(), l != 0, false, true, l, 2,
            kparams().norm_post + (l * 3 + 0) * 1024, 0.5f, true, l, 3, kparams().norm_pre + (l * 3 + 1) * 1024);
    SPAN_E(6);
    SPAN_B(1); xcd_barrier(xb); SPAN_E(1);
    for (int rep = 0; rep < REP_G; rep++) { SPAN_B(4); gemm_phase_k<2>(kparams(), l, 0, lds); SPAN_E(4); SPAN_B(1); xcd_barrier(xb); SPAN_E(1); }
    {
      volatile int* s_item = (volatile int*)(smem + 2 * HALF_SMEM);
      const int half = otid() >> 8;
      char* hs = smem + half * HALF_SMEM;
      SPAN_B(7);
      {
        unsigned* cnt = (unsigned*)(kparams().ws + OFF_CNT) + 64 * (2 * l);
        bool first = true;
        for (;;) {
          int q;
          if (first) { q = (int)blockIdx.x; first = false; }
          else {
            __syncthreads();
            if (otid() == 0) *s_item = (int)gridDim.x + (int)atomicAdd(cnt, 1u);
            __syncthreads();
            q = *s_item;
          }
          if (q >= 864) break;
          if (q < 32) { for (int rep = 0; rep < REP_FL; rep++) fourier_unit(kparams(), q, lds); }
          else if (q < 416 || q >= 672) { const int it = q < 416 ? (q - 32) * 2 + half : 768 + (q - 672) * 2 + half; for (int rep = 0; rep < REP_AL; rep++) attn_tile(kparams(), l, it, hs); }
          else { for (int rep = 0; rep < REP_SS; rep++) ssd_state_tile(kparams(), l, (q - 416) * 2 + half, hs); }
        }
      }
      SPAN_B(1); xcd_barrier(xb); SPAN_E(1);
      SPAN_E(7);
      SPAN_B(8); ssd_prefix(kparams(), l); SPAN_E(8);
      SPAN_B(9);
      SPAN_B(1); xcd_barrier(xb); SPAN_E(1);
      {
        unsigned* cnt = (unsigned*)(kparams().ws + OFF_CNT) + 64 * (2 * l + 1);
        bool first = true;
        for (;;) {
          int q;
          if (first) { q = (int)blockIdx.x; first = false; }
          else {
            __syncthreads();
            if (otid() == 0) *s_item = (int)gridDim.x + (int)atomicAdd(cnt, 1u);
            __syncthreads();
            q = *s_item;
          }
          if (q >= 480) break;
          if (q < 256) { for (int rep = 0; rep < REP_SO; rep++) ssd_out_tile(kparams(), l, q * 2 + half, hs); }
          else if (q < 448) { for (int rep = 0; rep < REP_AC; rep++) attn_tile(kparams(), l, 768 + 384 + (q - 256) * 2 + half, hs); }
          else fourier_unit(kparams(), 32 + (q - 448), lds);
        }
      }
      SPAN_B(1); xcd_barrier(xb); SPAN_E(1);
    }
    SPAN_E(9);
    for (int rep = 0; rep < REP_G; rep++) { SPAN_B(5); gemm_phase_k<3>(kparams(), l, 0, lds); SPAN_E(5); SPAN_B(1); xcd_barrier(xb); SPAN_E(1); }
    SPAN_B(6);
    rowpass(kparams(), true, false, true, l, 5, kparams().norm_post + (l * 3 + 1) * 1024, 1.0f, true, l, 6,
            kparams().norm_pre + (l * 3 + 2) * 1024);
    SPAN_E(6);
    SPAN_B(1); xcd_barrier(xb); SPAN_E(1);
    for (int rep = 0; rep < REP_G; rep++) { SPAN_B(2); gemm_phase_k<0>(kparams(), l, 1, lds); SPAN_E(2); SPAN_B(1); xcd_barrier(xb); SPAN_E(1); }
    for (int rep = 0; rep < REP_G; rep++) { SPAN_B(3); gemm_phase_k<1>(kparams(), l, 1, lds); SPAN_E(3); SPAN_B(1); xcd_barrier(xb); SPAN_E(1); }
    SPAN_B(6);
    rowpass(kparams(), true, l == 1, true, l, 8, kparams().norm_post + (l * 3 + 2) * 1024, 0.5f, l == 0, 1, 0,
            kparams().norm_pre + 3 * 1024);
    SPAN_E(6);
    if (l == 0) { SPAN_B(1); xcd_barrier(xb); SPAN_E(1); }
}

__global__ void __launch_bounds__(512, 2) mega(Params p_unused) {
  extern __shared__ __attribute__((aligned(16))) unsigned char dsm[];
  PG8_LAS unsigned char* lds = (PG8_LAS unsigned char*)dsm;
  char* smem = (char*)dsm;
  cg::grid_group grid = cg::this_grid();
  volatile LAS unsigned* xst = (volatile LAS unsigned*)(dsm + 2 * HALF_SMEM + 16);
  if (otid() == 0) { xst[0] = 0u; xst[1] = 0u; }
  __syncthreads();
  XcdBarrier xb = xcd_barrier_post((unsigned*)(kparams().ws + OFF_BAR), xst);
  unsigned long long span_acc = 0, span_t0 = 0;
  SPAN_B(10);
  for (int rep = 0; rep < REP_P0; rep++) { phase0(kparams(), smem, span_acc); xcd_barrier(xb); }
  if (kparams().ws == nullptr) grid.sync();
  SPAN_E(10);
  rowpass(kparams(), false, false, false, 0, 0, nullptr, 0.f, true, 0, 0, kparams().norm_pre);
  SPAN_B(1); xcd_barrier(xb); SPAN_E(1);
  layer_body<0>(xb, smem, lds, span_acc);
  layer_body<1>(xb, smem, lds, span_acc);
  if (PROBE_SPAN != 0 && blockIdx.x == 0) {
    const unsigned long long t_end = __builtin_amdgcn_s_memrealtime() + 2 * span_acc;
    while (__builtin_amdgcn_s_memrealtime() < t_end) __builtin_amdgcn_s_sleep(8);
  }
}

extern "C" void kernel_launch(void* const* d_in, const int* in_sizes, int n_in, void* d_out, int out_size, void* d_ws,
                              size_t ws_size, hipStream_t stream) {
  static int grid_blocks = 0;
  if (!grid_blocks) {
    int dev = 0, cus = 0, per_cu = 0;
    (void)hipGetDevice(&dev);
    (void)hipDeviceGetAttribute(&cus, hipDeviceAttributeMultiprocessorCount, dev);
    (void)hipFuncSetAttribute((const void*)mega, hipFuncAttributeMaxDynamicSharedMemorySize, DYN_SMEM);
    (void)hipOccupancyMaxActiveBlocksPerMultiprocessor(&per_cu, mega, 512, DYN_SMEM);
    if (per_cu > 1) per_cu = 1;
    if (per_cu < 1) per_cu = 1;
    grid_blocks = cus * per_cu;
  }
  if (ws_size < WS_NEED) fprintf(stderr, "workspace too small: %zu < %zu\n", ws_size, (size_t)WS_NEED);
  Params p{};
  const float** pp = (const float**)&p;
  for (int i = 0; i < 23; i++) pp[i] = (const float*)d_in[i];
  p.out = (float*)d_out;
  p.ws = (char*)d_ws;
  (void)hipMemsetAsync((char*)d_ws + OFF_CNT, 0, 1024 + 16384, stream);
  void* args[] = {&p};
  hipError_t e = hipLaunchCooperativeKernel((void*)mega, dim3(grid_blocks), dim3(512), args, DYN_SMEM, stream);
  if (e != hipSuccess) fprintf(stderr, "cooperative launch failed: %s (grid %d)\n", hipGetErrorString(e), grid_blocks);
}
```

```cpp
#include <hip/hip_runtime.h>
#include <hip/hip_cooperative_groups.h>
#include <cstdio>
#include <cstdint>
namespace cg = cooperative_groups;

typedef unsigned short bf16_t;
typedef __attribute__((ext_vector_type(8))) short bf16x8;
typedef __attribute__((ext_vector_type(4))) float f32x4;
typedef __attribute__((ext_vector_type(16))) float f32x16;
typedef __attribute__((ext_vector_type(4))) unsigned u32x4;

constexpr int NTOK = 16384;
constexpr int NCTX = 8192;
constexpr int LDU = 2192;
constexpr int U_Z = 0, U_XBC = 384, U_DT = 1024, U_Q = 1040, U_K = 1424, U_V = 1808;
constexpr int HALF_SMEM = 68096;
constexpr int DYN_SMEM = 2 * HALF_SMEM + 32;

constexpr size_t OFF_WT13 = 0;
constexpr size_t OFF_WT2 = OFF_WT13 + (size_t)4 * 5632 * 1024 * 2;
constexpr size_t OFF_WTIN = OFF_WT2 + (size_t)4 * 1024 * 2816 * 2;
constexpr size_t OFF_WTOUT = OFF_WTIN + (size_t)2 * 2816 * 1024 * 2;
constexpr size_t OFF_MODS = OFF_WTOUT + (size_t)2 * 1024 * 1024 * 2;
constexpr size_t OFF_DFTS = OFF_MODS + (size_t)2 * 5 * 9216 * 4;
constexpr size_t OFF_DFTL = OFF_DFTS + (size_t)256 * 512 * 2;
constexpr size_t OFF_H = OFF_DFTL + (size_t)2048 * 4096 * 2;
constexpr size_t OFF_Y = OFF_H + (size_t)NTOK * 1024 * 2;
constexpr size_t OFF_P16C = OFF_Y;
constexpr size_t OFF_P16L = OFF_Y + (size_t)32 * 4 * 12 * 4096 * 2;
constexpr size_t OFF_R1 = OFF_Y + (size_t)NTOK * 1024 * 2;
constexpr size_t OFF_ACT = OFF_R1;
constexpr size_t OFF_U = OFF_R1;
constexpr size_t OFF_ABC = OFF_U + (size_t)NTOK * LDU * 2;
constexpr size_t OFF_ABL = OFF_ABC + (size_t)32 * 256 * 512 * 2;
constexpr size_t OFF_MIX = OFF_H;
constexpr size_t OFF_XB = OFF_R1 + (size_t)NTOK * 2816 * 2;
constexpr size_t OFF_SC = OFF_XB + (size_t)NTOK * 1024 * 2;
constexpr size_t OFF_SL = OFF_SC + (size_t)32 * 4 * 6 * 2 * 4096 * 4;
constexpr size_t OFF_DC = OFF_SL + (size_t)4 * 32 * 6 * 2 * 4096 * 4;
constexpr size_t OFF_DL = OFF_DC + (size_t)32 * 4 * 12 * 4;
constexpr size_t OFF_CK16 = OFF_DL + (size_t)4 * 32 * 12 * 4;
constexpr size_t OFF_CV16 = OFF_CK16 + (size_t)4 * 2 * 512 * 384 * 2;
constexpr size_t OFF_ROPE = OFF_CV16 + (size_t)4 * 2 * 512 * 384 * 2;
constexpr size_t OFF_CNT = OFF_ROPE + 8192;
constexpr size_t OFF_BAR = OFF_CNT + 1024;
constexpr size_t WS_NEED = OFF_BAR + 16384;

constexpr size_t OUT_SF = (size_t)2 * 8192 * 1024;
constexpr size_t OUT_SB = OUT_SF + (size_t)32 * 2 * 6 * 4096;
constexpr size_t OUT_CK = OUT_SB + (size_t)32 * 2 * 6 * 4096;
constexpr size_t OUT_CV = OUT_CK + (size_t)32 * 2 * 256 * 384;

struct Params {
  const float *x_prompt, *x_sample, *c, *st_f, *st_b, *ck, *cv, *c_ctx, *mod_w, *mod_b, *norm_pre, *norm_post,
      *w13, *w2, *w_in, *w_out, *conv_w, *conv_b, *dt_bias, *a_log, *ssd_d, *ssd_norm, *rpb;
  float* out;
  char* ws;
};

#if defined(__HIP_DEVICE_COMPILE__)
__device__ __forceinline__ const Params kparams() {
  auto k = __builtin_amdgcn_kernarg_segment_ptr();
  asm volatile("" : "+s"(k));
  return *(decltype((const Params __attribute__((address_space(4)))*)k))k;
}
#else
__device__ inline const Params kparams() { return Params{}; }
#endif
#ifndef PROBE_SPAN
#define PROBE_SPAN 0
#endif
#define SPAN_B(id) do { if (PROBE_SPAN == (id)) span_t0 = __builtin_amdgcn_s_memrealtime(); } while (0)
#define SPAN_E(id) do { if (PROBE_SPAN == (id)) span_acc += __builtin_amdgcn_s_memrealtime() - span_t0; } while (0)
__device__ __forceinline__ int otid4();
__device__ __forceinline__ int otid() { int t = threadIdx.x; asm volatile("" : "+v"(t)); return t; }
__device__ __forceinline__ unsigned f2bf(float f) {
  unsigned u = __float_as_uint(f);
  u += 0x7fffu + ((u >> 16) & 1u);
  return u >> 16;
}
__device__ __forceinline__ float bf2f(bf16_t h) { return __uint_as_float(((unsigned)h) << 16); }
__device__ __forceinline__ unsigned pack2(float a, float b) { return f2bf(a) | (f2bf(b) << 16); }
__device__ __forceinline__ void unpack8(uint4 r, float (&f)[8]) {
  f[0] = __uint_as_float(r.x << 16); f[1] = __uint_as_float(r.x & 0xffff0000u);
  f[2] = __uint_as_float(r.y << 16); f[3] = __uint_as_float(r.y & 0xffff0000u);
  f[4] = __uint_as_float(r.z << 16); f[5] = __uint_as_float(r.z & 0xffff0000u);
  f[6] = __uint_as_float(r.w << 16); f[7] = __uint_as_float(r.w & 0xffff0000u);
}
__device__ __forceinline__ uint4 pack8(const float (&f)[8]) {
  uint4 r;
  r.x = pack2(f[0], f[1]); r.y = pack2(f[2], f[3]); r.z = pack2(f[4], f[5]); r.w = pack2(f[6], f[7]);
  return r;
}
__device__ __forceinline__ bf16x8 as_frag(uint4 r) { return __builtin_bit_cast(bf16x8, r); }
__device__ __forceinline__ float silu_f(float x) { return x * __builtin_amdgcn_rcpf(1.f + __builtin_amdgcn_exp2f(x * -1.4426950408889634f)); }
__device__ __forceinline__ float wave_sum(float v) {
#pragma unroll
  for (int o = 32; o > 0; o >>= 1) v += __shfl_xor(v, o, 64);
  return v;
}
__device__ __forceinline__ float grp16_sum(float v) {
#pragma unroll
  for (int o = 8; o > 0; o >>= 1) v += __shfl_xor(v, o, 64);
  return v;
}
__device__ __forceinline__ float grp16_max(float v) {
#pragma unroll
  for (int o = 8; o > 0; o >>= 1) v = fmaxf(v, __shfl_xor(v, o, 64));
  return v;
}

__device__ __forceinline__ int otid4() { return otid() & 255; }
namespace pg8 {
#define PG8_LAS __attribute__((address_space(3)))
typedef unsigned short bf16_t;
typedef short bf16x8 __attribute__((ext_vector_type(8)));
typedef float f32x4 __attribute__((ext_vector_type(4)));
typedef unsigned u32x4 __attribute__((ext_vector_type(4)));
constexpr int BM = 256, BK = 64, HALF = 128, HTB = HALF * BK * 2  , STAGE_BYTES = 8 * HTB, NXCD = 8, WGM = 4;

__host__ __device__ __forceinline__ int lds_byte(int r, int c) { const int st = (r >> 4) * 2 + (c >> 5), rr = r & 15, cc = c & 31, ob = rr * 64 + cc * 2; return st * 1024 + (ob ^ (((ob >> 9) & 1) << 5)); }
__host__ __device__ __forceinline__ void stage_rc(int b, int& R, int& C) { const int st = b / 1024, sb = b % 1024, swz = sb ^ (((sb >> 9) & 1) << 5); R = (st >> 1) * 16 + swz / 64; C = (st & 1) * 32 + (swz % 64) / 2; }
__host__ __device__ __forceinline__ int perm32(int rho) { const int n = rho >> 4, i = rho & 15; return 8 * (i >> 2) + 4 * n + (i & 3); }

struct Unit { int pm, pn; };
struct Gemm { const bf16_t* A; const bf16_t* Bt; int M, N, K; };

struct StaticOrder {
    int nM, nN, nwg, G, c;
    __host__ __device__ void init(int M, int N, int G_, int c_) { nM = M / BM; nN = N / BM; nwg = nM * nN; G = G_; c = c_; }
    __host__ __device__ bool next(int i, Unit& u) const {
        const long L = (long)i * G + c; if (L >= nwg) return false;
        int wgid = (int)L; { const int q = nwg / NXCD, r = nwg % NXCD, xcd = wgid % NXCD, off = wgid / NXCD; wgid = (xcd < r ? xcd * (q + 1) : r * (q + 1) + (xcd - r) * q) + off; }
        const int nig = WGM * nN, gid = wgid / nig, fm = gid * WGM, gsz = (nM - fm) < WGM ? (nM - fm) : WGM;
        u.pm = fm + ((wgid % nig) % gsz); u.pn = (wgid % nig) / gsz; return true;
    }
    __device__ __forceinline__ void a_ready(const Unit&) const {}
    __device__ __forceinline__ void done(const Unit&) const {}
};
__device__ __forceinline__ unsigned cvt_pk_bf16(float lo, float hi) { unsigned r; asm volatile("v_cvt_pk_bf16_f32 %0, %1, %2" : "=v"(r) : "v"(lo), "v"(hi)); return r; }
template <class Epi, class Sched, bool STAMP = false>
__device__ __forceinline__ void gemm_phase(PG8_LAS unsigned char* lds, const Gemm g, const Sched& S, const Epi& E, unsigned long long* stamps) {
    const int tid = otid(), wid = __builtin_amdgcn_readfirstlane(tid >> 6), lane = tid & 63, wr = wid >> 2, wc = wid & 3, fr = lane & 15, fq = lane >> 4;
    const int K = g.K, nt = K / BK;
    int ts_lo = 0, ts_hi = 0, nts = 0; const unsigned long long rt_entry = STAMP ? (unsigned long long)wall_clock64() : 0ull;
#define PG8_STAMP() do { if (STAMP && wid == 0 && nts < 64) { const unsigned long long _c = (unsigned long long)clock64(); \
        ts_lo = (lane == nts) ? (int)(unsigned)_c : ts_lo; ts_hi = (lane == nts) ? (int)(unsigned)(_c >> 32) : ts_hi; ++nts; } } while (0)
    PG8_STAMP();
    unsigned voffA[2], voffB[2];
#pragma unroll
    for (int i = 0; i < 2; ++i) { int R, C; stage_rc(tid * 16 + i * 8192, R, C); const int Rb = Epi::PERM ? ((R & ~31) + perm32(R & 31)) : R;
        voffA[i] = (unsigned)(R * K + C) * 2u; voffB[i] = (unsigned)(Rb * K + C) * 2u; }
    const size_t kstep = (size_t)(BK * 2);
    const size_t hstep = (size_t)HALF * K * 2;
    const size_t tstep = 2 * hstep;
    const unsigned ldsw = (unsigned)wid * 1024u;
    const int aoff = lds_byte(wr * 64 + fr, fq * 8), boff = lds_byte(wc * 32 + fr, fq * 8);
#define PG8_SA(b, h) (((b) * 2 + (h)) * HTB)
#define PG8_SB(b, h) ((4 + (b) * 2 + (h)) * HTB)
#define PG8_STAGE(bufoff, gbase, voff) do { _Pragma("unroll") for (int _i = 0; _i < 2; ++_i) \
        __builtin_amdgcn_global_load_lds((const unsigned*)((const char*)(gbase) + (voff)[_i]), (PG8_LAS unsigned*)(lds + (bufoff) + ldsw + _i * 8192), 16, 0, 0); } while (0)
#define PG8_LDA(dst, b, h) do { _Pragma("unroll") for (int m = 0; m < 4; ++m) _Pragma("unroll") for (int k = 0; k < 2; ++k) dst[m][k] = *(const PG8_LAS bf16x8*)(lds + PG8_SA(b, h) + aoff + m * 2048 + k * 1024); } while (0)
#define PG8_LDB(dst, b, h) do { _Pragma("unroll") for (int n = 0; n < 2; ++n) _Pragma("unroll") for (int k = 0; k < 2; ++k) dst[n][k] = *(const PG8_LAS bf16x8*)(lds + PG8_SB(b, h) + boff + n * 2048 + k * 1024); } while (0)
#define PG8_MMA(ai, bj, At, Bt) do { __builtin_amdgcn_s_setprio(1); _Pragma("unroll") for (int m = 0; m < 4; ++m) _Pragma("unroll") for (int n = 0; n < 2; ++n) _Pragma("unroll") for (int k = 0; k < 2; ++k) \
        acc[ai][bj][m][n] = __builtin_amdgcn_mfma_f32_16x16x32_bf16(Bt[n][k], At[m][k], acc[ai][bj][m][n], 0, 0, 0); __builtin_amdgcn_s_setprio(0); } while (0)
#define PG8_WAIT_V(n) asm volatile("s_waitcnt vmcnt(" #n ")" ::: "memory")
#define PG8_WAIT_L(n) asm volatile("s_waitcnt lgkmcnt(" #n ")" ::: "memory")
#define PG8_BAR __builtin_amdgcn_s_barrier()
#define PG8_SCHED __builtin_amdgcn_sched_barrier(0)
    Unit cur, nxt; int ui = 0;
    if (!S.next(0, cur)) return;
    f32x4 acc[2][2][4][2];
#pragma unroll
    for (int a = 0; a < 2; ++a)
#pragma unroll
        for (int b = 0; b < 2; ++b)
#pragma unroll
            for (int m = 0; m < 4; ++m)
#pragma unroll
                for (int n = 0; n < 2; ++n) acc[a][b][m][n] = (f32x4){0.f, 0.f, 0.f, 0.f};
    bf16x8 At[4][2], B0[2][2], B1[2][2];
    const char* cA = (const char*)g.A + (size_t)cur.pm * tstep; const char* cB = (const char*)g.Bt + (size_t)cur.pn * tstep;
    S.a_ready(cur);
    PG8_STAGE(PG8_SB(0, 0), cB, voffB); PG8_STAGE(PG8_SA(0, 0), cA, voffA); PG8_STAGE(PG8_SB(0, 1), cB + hstep, voffB); PG8_STAGE(PG8_SA(0, 1), cA + hstep, voffA);
    if (wr == 1) PG8_BAR;
    PG8_WAIT_V(4); PG8_BAR;
    PG8_STAGE(PG8_SB(1, 0), cB + kstep, voffB); PG8_STAGE(PG8_SA(1, 0), cA + kstep, voffA); PG8_STAGE(PG8_SB(1, 1), cB + hstep + kstep, voffB);
    PG8_WAIT_V(6); PG8_BAR;
    PG8_STAMP();
    for (;;) {
        const bool has_next = S.next(ui + 1, nxt);
        const char* nA = has_next ? (const char*)g.A + (size_t)nxt.pm * tstep : cA; const char* nB = has_next ? (const char*)g.Bt + (size_t)nxt.pn * tstep : cB;
        for (int t = 0; t < nt; t += 2) {
            const bool last = (t == nt - 2);
            const char* a1 = cA + (size_t)(t + 1) * kstep;
            const char* a2 = last ? nA : cA + (size_t)(t + 2) * kstep; const char* b2 = last ? nB : cB + (size_t)(t + 2) * kstep;
            const char* a3 = a2 + kstep; const char* b3 = b2 + kstep;
            if (last && has_next) S.a_ready(nxt);
            PG8_LDB(B0, 0, 0); PG8_SCHED; PG8_LDA(At, 0, 0); PG8_STAGE(PG8_SA(1, 1), a1 + hstep, voffA);
            PG8_WAIT_L(8); PG8_BAR; PG8_WAIT_L(0); PG8_MMA(0, 0, At, B0); PG8_BAR; PG8_SCHED;
            PG8_LDB(B1, 0, 1); PG8_STAGE(PG8_SB(0, 0), b2, voffB);
            PG8_BAR; PG8_WAIT_L(0); PG8_MMA(0, 1, At, B1); PG8_BAR;
            PG8_LDA(At, 0, 1); PG8_STAGE(PG8_SA(0, 0), a2, voffA);
            PG8_BAR; PG8_WAIT_L(0); PG8_MMA(1, 0, At, B0); PG8_BAR; PG8_SCHED;
            PG8_STAGE(PG8_SB(0, 1), b2 + hstep, voffB);
            PG8_WAIT_V(6); PG8_BAR; PG8_MMA(1, 1, At, B1); PG8_BAR;
            PG8_LDB(B0, 1, 0); PG8_SCHED; PG8_LDA(At, 1, 0); PG8_STAGE(PG8_SA(0, 1), a2 + hstep, voffA);
            PG8_WAIT_L(8); PG8_BAR; PG8_WAIT_L(0); PG8_MMA(0, 0, At, B0); PG8_BAR; PG8_SCHED;
            PG8_LDB(B1, 1, 1); PG8_STAGE(PG8_SB(1, 0), b3, voffB);
            PG8_BAR; PG8_WAIT_L(0); PG8_MMA(0, 1, At, B1); PG8_BAR;
            PG8_LDA(At, 1, 1); PG8_STAGE(PG8_SA(1, 0), a3, voffA);
            PG8_BAR; PG8_WAIT_L(0); PG8_MMA(1, 0, At, B0); PG8_BAR; PG8_SCHED;
            PG8_STAGE(PG8_SB(1, 1), b3 + hstep, voffB);
            PG8_WAIT_V(6); PG8_BAR; PG8_MMA(1, 1, At, B1); PG8_BAR;
        }
        PG8_STAMP();
        if constexpr (!Epi::AFTER_DRAIN) { E(acc, cur, wr, wc, fr, fq); S.done(cur); }
        PG8_STAMP();
        if (!has_next) break;
#pragma unroll
        for (int a = 0; a < 2; ++a)
#pragma unroll
            for (int b = 0; b < 2; ++b)
#pragma unroll
                for (int m = 0; m < 4; ++m)
#pragma unroll
                    for (int n = 0; n < 2; ++n) acc[a][b][m][n] = (f32x4){0.f, 0.f, 0.f, 0.f};
        cur = nxt; cA = nA; cB = nB; ++ui;
    }
    PG8_WAIT_V(0);
    if (wr == 0) PG8_BAR;
    PG8_BAR;
    if constexpr (Epi::AFTER_DRAIN) { E.fused(acc, cur, wr, wc, fr, fq, lds, wid, lane); S.done(cur); }
    PG8_STAMP();
    if (STAMP && wid == 0) { stamps[lane] = lane < nts ? (((unsigned long long)(unsigned)ts_hi << 32) | (unsigned)ts_lo) : 0ull;
        if (lane == 62) stamps[62] = rt_entry; if (lane == 63) stamps[63] = (unsigned long long)wall_clock64(); }
#undef PG8_STAMP
#undef PG8_SA
#undef PG8_SB
#undef PG8_STAGE
#undef PG8_LDA
#undef PG8_LDB
#undef PG8_MMA
#undef PG8_WAIT_V
#undef PG8_WAIT_L
#undef PG8_BAR
#undef PG8_SCHED
}
}

__device__ __forceinline__ int map_w13(int j) {
  int pn = j >> 8, bj = (j >> 7) & 1, oc = pn * 128 + (j & 127);
  return bj ? 2816 + oc : oc;
}
__device__ __forceinline__ int map_win(int n) {
  if (n < 896) return 256 + (n - 512);
  if (n < 1536) return 640 + (n - 896);
  if (n < 1552) { int d = n - 1536; return d < 12 ? 1280 + d : -1; }
  if (n < 1936) return 1292 + (n - 1552);
  if (n < 2320) return 1676 + (n - 1936);
  if (n < 2704) return 2060 + (n - 2320);
  return -1;
}

struct XT { const float* src; bf16_t* dst; int lds, ldd, sc; float msk; };
constexpr int XP_L = 1408 + 704 + 288 + 128;
constexpr int N_XP = 2 * XP_L;
__device__ __forceinline__ XT xt_decode(const Params& p, int item, int n4) {
  XT x;
  const int l = item / XP_L, r = item % XP_L;
  int n0, k0, mapkind;
  if (r < 1408) {
    const int s = r / 704, q = r % 704;
    n0 = (q / 8) * 64; k0 = (q % 8) * 128; mapkind = 0;
    x.src = p.w13 + (size_t)(l * 2 + s) * 1024 * 5632; x.lds = 5632;
    x.dst = (bf16_t*)(p.ws + OFF_WT13) + (size_t)(l * 2 + s) * 5632 * 1024; x.ldd = 1024;
  } else if (r < 1408 + 704) {
    const int q0 = r - 1408, s = q0 / 352, q = q0 % 352;
    n0 = (q / 22) * 64; k0 = (q % 22) * 128; mapkind = 1;
    x.src = p.w2 + (size_t)(l * 2 + s) * 2816 * 1024; x.lds = 1024;
    x.dst = (bf16_t*)(p.ws + OFF_WT2) + (size_t)(l * 2 + s) * 1024 * 2816; x.ldd = 2816;
  } else if (r < 1408 + 704 + 288) {
    const int q = r - 1408 - 704;
    n0 = 512 + (q / 8) * 64; k0 = (q % 8) * 128; mapkind = 2;
    x.src = p.w_in + (size_t)l * 1024 * 2444; x.lds = 2444;
    x.dst = (bf16_t*)(p.ws + OFF_WTIN) + (size_t)l * 2816 * 1024; x.ldd = 1024;
  } else {
    const int q = r - 1408 - 704 - 288;
    n0 = (q / 8) * 64; k0 = (q % 8) * 128; mapkind = 1;
    x.src = p.w_out + (size_t)l * 1024 * 1024; x.lds = 1024;
    x.dst = (bf16_t*)(p.ws + OFF_WTOUT) + (size_t)l * 1024 * 1024; x.ldd = 1024;
  }
  const int n = n0 + n4;
  const int sc = mapkind == 0 ? map_w13(n) : (mapkind == 2 ? map_win(n) : n);
  x.sc = sc >= 0 ? sc : 0; x.msk = sc >= 0 ? 1.f : 0.f;
  x.src += (size_t)k0 * x.lds;
  x.dst += (size_t)n0 * x.ldd + k0;
  return x;
}
__device__ __forceinline__ void xt_load(const XT& x, int kk, f32x4 (&v)[8]) {
#pragma unroll
  for (int i = 0; i < 8; i++) v[i] = *(const f32x4*)(x.src + (size_t)(kk + 16 * i) * x.lds + x.sc);
}
__device__ __forceinline__ void xt_step(const Params& p, const XT& cur, bool cur_valid, int nxt_item, int tid, float* tile, f32x4 (&v)[8]) {
  const int kk = tid >> 4, n4 = (tid & 15) * 4;
  __syncthreads();
#pragma unroll
  for (int i = 0; i < 8; i++) *(f32x4*)(tile + (kk + 16 * i) * 68 + n4) = v[i] * cur.msk;
  __syncthreads();
  const XT nx = xt_decode(p, nxt_item, n4);
  xt_load(nx, kk, v);
  const int nn = tid >> 2, kq = (tid & 3) * 32;
  if (cur_valid) {
    float f[8];
#pragma unroll
    for (int hh = 0; hh < 4; hh++) {
#pragma unroll
      for (int e = 0; e < 8; e++) f[e] = tile[(kq + hh * 8 + e) * 68 + nn];
      *(uint4*)(cur.dst + (size_t)nn * cur.ldd + kq + hh * 8) = pack8(f);
    }
  }
}
__device__ __forceinline__ void xpose_all(const Params& p, float* tile) {
  const int tid = otid4(), half = otid() >> 8;
  const int kk = tid >> 4, n4 = (tid & 15) * 4;
  const int stride = gridDim.x * 2;
  const int first = blockIdx.x * 2 + half;
  const int n_it = (N_XP - blockIdx.x * 2 + stride - 1) / stride;
  f32x4 vA[8], vB[8];
  XT xa = xt_decode(p, min(first, N_XP - 1), n4);
  XT xb = xt_decode(p, min(first + stride, N_XP - 1), n4);
  xt_load(xa, kk, vA);
  xt_load(xb, kk, vB);
#pragma unroll 1
  for (int it = 0; it < n_it; it += 2) {
    const int ia = first + it * stride, ib = ia + stride;
    xt_step(p, xa, ia < N_XP, min(ia + 2 * stride, N_XP - 1), tid, tile, vA);
    xa = xt_decode(p, min(ia + 2 * stride, N_XP - 1), n4);
    xt_step(p, xb, ib < N_XP, min(ib + 2 * stride, N_XP - 1), tid, tile, vB);
    xb = xt_decode(p, min(ib + 2 * stride, N_XP - 1), n4);
  }
}

__device__ __forceinline__ void fourier_w_tile(const float* __restrict__ win, bf16_t* __restrict__ dst, int k0, int n0, float* tile) {
  const int tid = otid4(), a = tid & 63, b = tid >> 6;
  const int part = n0 >> 8, g = (n0 >> 6) & 3;
  float* trig = tile + 64 * 65;
  __syncthreads();
#pragma unroll 4
  for (int i = 0; i < 16; i++) {
    int kk = b + 4 * i;
    tile[kk * 65 + a] = win[(size_t)(k0 + kk) * 2444 + g * 64 + a];
  }
  if (tid < 64) {
    float ang = (float)tid * (6.283185307179586f / 64.f);
    trig[tid] = part ? __sinf(ang) : __cosf(ang);
  }
  __syncthreads();
  for (int i = 0; i < 16; i++) {
    int m = b + 4 * i;
    float acc = 0.f;
#pragma unroll 8
    for (int c = 0; c < 64; c++) acc += tile[a * 65 + c] * trig[(m * c) & 63];
    dst[(size_t)(n0 + m) * 1024 + k0 + a] = (bf16_t)f2bf(acc);
  }
}

__device__ __forceinline__ void mods_item(const Params& p, int item, const float* sv, float* red) {
  const int tid = otid4();
  const int l = item / 288, cgp = item % 288;
  __syncthreads();
  const int kg = tid >> 5, jj = tid & 31;
  float acc0 = 0.f, acc1 = 0.f, acc2 = 0.f, acc3 = 0.f, acc4 = 0.f;
  const float* wp = p.mod_w + (size_t)l * 1024 * 9216 + cgp * 32 + jj;
#pragma unroll 1
  for (int kb = kg * 128; kb < kg * 128 + 128; kb += 64) {
    float wv[64];
#pragma unroll
    for (int j = 0; j < 64; j++) wv[j] = wp[(size_t)(kb + j) * 9216];
#pragma unroll
    for (int j = 0; j < 64; j++) {
      const int k = kb + j;
      acc0 += sv[k] * wv[j]; acc1 += sv[1024 + k] * wv[j]; acc2 += sv[2048 + k] * wv[j]; acc3 += sv[3072 + k] * wv[j];
      acc4 += sv[4096 + k] * wv[j];
    }
  }
  red[(kg * 5 + 0) * 32 + jj] = acc0; red[(kg * 5 + 1) * 32 + jj] = acc1; red[(kg * 5 + 2) * 32 + jj] = acc2;
  red[(kg * 5 + 3) * 32 + jj] = acc3; red[(kg * 5 + 4) * 32 + jj] = acc4;
  __syncthreads();
  float* mods = (float*)(p.ws + OFF_MODS);
  if (tid < 160) {
    int v = tid >> 5, j2 = tid & 31;
    float s = 0.f;
#pragma unroll
    for (int q = 0; q < 8; q++) s += red[(q * 5 + v) * 32 + j2];
    s += p.mod_b[l * 9216 + cgp * 32 + j2];
    mods[(size_t)(l * 5 + v) * 9216 + cgp * 32 + j2] = s;
  }
}

__device__ __forceinline__ void dft_item(const Params& p, int item) {
  const int tid = otid4();
  int L, e0; bf16_t* dst;
  if (item < 64) { L = 256; e0 = item * 2048 + tid * 8; dst = (bf16_t*)(p.ws + OFF_DFTS); }
  else { L = 2048; e0 = (item - 64) * 2048 + tid * 8; dst = (bf16_t*)(p.ws + OFF_DFTL); }
  const int k = e0 / (2 * L), t0 = e0 % (2 * L);
  const float sc = rsqrtf(64.f * (float)L);
  const float w = 6.283185307179586f / (float)L;
  float f[8];
#pragma unroll
  for (int j = 0; j < 8; j++) {
    int tt = t0 + j;
    bool isin = tt >= L;
    int t = isin ? tt - L : tt;
    int r = (k * t) & (L - 1);
    float ang = (float)r * w;
    f[j] = isin ? -__sinf(ang) * sc : __cosf(ang) * sc;
  }
  *(uint4*)(dst + (size_t)e0) = pack8(f);
}

__device__ __forceinline__ void phase0(const Params& p, char* smem, unsigned long long& span_acc) {
  unsigned long long span_t0 = 0;
  const int half = otid() >> 8;
  float* tile = (float*)(smem + half * HALF_SMEM);
  if (blockIdx.x == 1) {
    for (int i = otid(); i < 1024; i += 512) {
      const int pos = i >> 4, idx = i & 15;
      const float ang = (float)pos * exp2f(-(float)idx * (13.287712379549449f / 16.f));
      ((float2*)(p.ws + OFF_ROPE))[i] = make_float2(__cosf(ang), __sinf(ang));
    }
  }
  SPAN_B(11); xpose_all(p, tile); SPAN_E(11);
  SPAN_B(12);
  constexpr int N_M = 576, N_X = 256, N_D = (64 + 4096) / 4, N_C = 1536 / 4;
  float* sv = (float*)(smem + half * HALF_SMEM + 36864);
  float* red = sv + 5 * 1024;
  for (int i = otid4(); i < 5 * 1024; i += 256) {
    int v = i >> 10, k = i & 1023;
    float x = v == 0 ? p.c_ctx[k] : p.c[(v - 1) * 1024 + k];
    sv[i] = silu_f(x);
  }
  unsigned* cnt0 = (unsigned*)(p.ws + OFF_CNT) + 224;
  volatile int* s_item = (volatile int*)(smem + 2 * HALF_SMEM);
  bool first0 = true;
  for (;;) {
    int pq;
    if (first0) { pq = (int)blockIdx.x; first0 = false; }
    else {
      __syncthreads();
      if (otid() == 0) *s_item = (int)gridDim.x + (int)atomicAdd(cnt0, 1u);
      __syncthreads();
      pq = *s_item;
    }
    const int item = pq * 2 + half;
    if (item >= N_M + N_X + N_D + N_C) break;
    if (item < N_M) {
      mods_item(p, item, sv, red);
    } else if (item < N_M + N_X) {
      const int it = item - N_M;
      const int l = it / 128, q = it % 128;
      const int nt = q / 16, kt = q % 16;
      fourier_w_tile(p.w_in + (size_t)l * 1024 * 2444, (bf16_t*)(p.ws + OFF_WTIN) + (size_t)l * 2816 * 1024, kt * 64, nt * 64, tile);
    } else if (item < N_M + N_X + N_D) {
      for (int sub = 0; sub < 4; sub++) dft_item(p, (item - N_M - N_X) * 4 + sub);
    } else {
      const int it4 = item - N_M - N_X - N_D;
      float4 a0[4], a1[4];
#pragma unroll
      for (int sub = 0; sub < 4; sub++) {
        const int it = it4 * 4 + sub;
        const float* src = it < 768 ? p.ck : p.cv;
        const size_t e0 = (size_t)(it % 768) * 2048 + (size_t)otid4() * 8;
        a0[sub] = *(const float4*)(src + e0); a1[sub] = *(const float4*)(src + e0 + 4);
      }
#pragma unroll
      for (int sub = 0; sub < 4; sub++) {
        const int it = it4 * 4 + sub;
        bf16_t* dst = (bf16_t*)(p.ws + (it < 768 ? OFF_CK16 : OFF_CV16));
        const size_t e0 = (size_t)(it % 768) * 2048 + (size_t)otid4() * 8;
        float f[8] = {a0[sub].x, a0[sub].y, a0[sub].z, a0[sub].w, a1[sub].x, a1[sub].y, a1[sub].z, a1[sub].w};
        *(uint4*)(dst + e0) = pack8(f);
      }
    }
  }
  SPAN_E(12);
}

__device__ __forceinline__ void rowpass(const Params& p, bool src_bf16, bool dst_f32, bool has_post,
                        int lpost, int gi, const float* __restrict__ gpost, float mult, bool has_pre, int lpre, int si,
                        const float* __restrict__ gpre) {
  const bf16_t* y = (const bf16_t*)(p.ws + OFF_Y);
  bf16_t* h = (bf16_t*)(p.ws + OFF_H);
  const float* mods = (const float*)(p.ws + OFF_MODS);
  const int wave = otid() >> 6, lane = otid() & 63;
  const int nw = gridDim.x * 8;
  for (int r0 = (blockIdx.x * 8 + wave) * 4; r0 < NTOK; r0 += 4 * nw) {
    float4 xv[4][4]; uint2 yr[4][4];
    float4 gpo[4], gpr[4], gt[1][4], sh4[1][4], sc4[1][4];
#pragma unroll
    for (int it = 0; it < 4; it++) {
      if (has_post) gpo[it] = *(const float4*)(gpost + it * 256 + lane * 4);
      if (has_pre) gpr[it] = *(const float4*)(gpre + it * 256 + lane * 4);
    }
#pragma unroll
    for (int q = 0; q < 4; q++) {
      const int row = r0 + q;
      const int rr = row;
      const int v = rr < NCTX ? 0 : 1 + ((rr - NCTX) >> 11);
      if (src_bf16) {
        const bf16_t* xb = (const bf16_t*)(p.ws + OFF_XB) + (size_t)rr * 1024;
#pragma unroll
        for (int it = 0; it < 4; it++) {
          uint2 raw = *(const uint2*)(xb + it * 256 + lane * 4);
          xv[q][it] = make_float4(__uint_as_float(raw.x << 16), __uint_as_float(raw.x & 0xffff0000u), __uint_as_float(raw.y << 16), __uint_as_float(raw.y & 0xffff0000u));
        }
      } else {
        const float* xr = rr < NCTX ? p.x_prompt + (size_t)rr * 1024 : p.x_sample + (size_t)(rr - NCTX) * 1024;
#pragma unroll
        for (int it = 0; it < 4; it++) { f32x4 t_ = __builtin_nontemporal_load((const f32x4*)(xr + it * 256 + lane * 4)); xv[q][it] = make_float4(t_[0], t_[1], t_[2], t_[3]); }
      }
      if (has_post) {
        const float* gm = mods + (size_t)(lpost * 5 + v) * 9216 + gi * 1024;
#pragma unroll
        for (int it = 0; it < 4; it++) {
          yr[q][it] = *(const uint2*)(y + (size_t)rr * 1024 + it * 256 + lane * 4);
          if (q == 0) gt[0][it] = *(const float4*)(gm + it * 256 + lane * 4);
        }
      }
      if (has_pre) {
        const float* sh = mods + (size_t)(lpre * 5 + v) * 9216 + si * 1024;
#pragma unroll
        for (int it = 0; it < 4; it++) {
          if (q == 0) { sh4[0][it] = *(const float4*)(sh + it * 256 + lane * 4); sc4[0][it] = *(const float4*)(sh + 1024 + it * 256 + lane * 4); }
        }
      }
    }
#pragma unroll
    for (int q = 0; q < 4; q++) {
      const int row = r0 + q;
      if (has_post) {
        float4 yv[4];
        float ss = 0.f;
#pragma unroll
        for (int it = 0; it < 4; it++) {
          uint2 raw = yr[q][it];
          yv[it].x = __uint_as_float(raw.x << 16); yv[it].y = __uint_as_float(raw.x & 0xffff0000u);
          yv[it].z = __uint_as_float(raw.y << 16); yv[it].w = __uint_as_float(raw.y & 0xffff0000u);
          ss += yv[it].x * yv[it].x + yv[it].y * yv[it].y + yv[it].z * yv[it].z + yv[it].w * yv[it].w;
        }
        ss = wave_sum(ss);
        const float r = rsqrtf(ss * (1.f / 1024.f) + 1e-6f) * mult;
#pragma unroll
        for (int it = 0; it < 4; it++) {
          const float4 g = gt[0][it], gp = gpo[it];
          xv[q][it].x += g.x * (yv[it].x * r * gp.x); xv[q][it].y += g.y * (yv[it].y * r * gp.y);
          xv[q][it].z += g.z * (yv[it].z * r * gp.z); xv[q][it].w += g.w * (yv[it].w * r * gp.w);
          if (dst_f32) { f32x4 t_ = {xv[q][it].x, xv[q][it].y, xv[q][it].z, xv[q][it].w}; __builtin_nontemporal_store(t_, (f32x4*)(p.out + (size_t)row * 1024 + it * 256 + lane * 4)); }
          else { uint2 o; o.x = pack2(xv[q][it].x, xv[q][it].y); o.y = pack2(xv[q][it].z, xv[q][it].w); *(uint2*)((bf16_t*)(p.ws + OFF_XB) + (size_t)row * 1024 + it * 256 + lane * 4) = o; }
        }
      }
      if (has_pre) {
        float ss = 0.f;
#pragma unroll
        for (int it = 0; it < 4; it++)
          ss += xv[q][it].x * xv[q][it].x + xv[q][it].y * xv[q][it].y + xv[q][it].z * xv[q][it].z + xv[q][it].w * xv[q][it].w;
        ss = wave_sum(ss);
        const float r = rsqrtf(ss * (1.f / 1024.f) + 1e-6f);
#pragma unroll
        for (int it = 0; it < 4; it++) {
          const float4 g = gpr[it], s4 = sh4[0][it], c4 = sc4[0][it];
          float h0 = xv[q][it].x * r * g.x * (1.f + c4.x) + s4.x;
          float h1 = xv[q][it].y * r * g.y * (1.f + c4.y) + s4.y;
          float h2 = xv[q][it].z * r * g.z * (1.f + c4.z) + s4.z;
          float h3 = xv[q][it].w * r * g.w * (1.f + c4.w) + s4.w;
          uint2 o; o.x = pack2(h0, h1); o.y = pack2(h2, h3);
          *(uint2*)(h + (size_t)row * 1024 + it * 256 + lane * 4) = o;
        }
      }
    }
  }
}

struct WinOrder {
  int c;
  __device__ bool next(int i, pg8::Unit& u) const {
    const int xcd = c & 7;
    if (c < 192) { if (i >= 3) return false; const int uu = i * 24 + (c >> 3); u.pm = 8 * xcd + (uu & 7); u.pn = 2 + (uu >> 3); return true; }
    if (i >= 2) return false;
    u.pm = 8 * xcd + ((c - 192) >> 3); u.pn = i; return true;
  }
  __device__ __forceinline__ void a_ready(const pg8::Unit&) const {}
  __device__ __forceinline__ void done(const pg8::Unit&) const {}
};
struct OneUnit {
  int pm, pn;
  __device__ bool next(int i, pg8::Unit& u) const { if (i) return false; u.pm = pm; u.pn = pn; return true; }
  __device__ __forceinline__ void a_ready(const pg8::Unit&) const {}
  __device__ __forceinline__ void done(const pg8::Unit&) const {}
};
__device__ __forceinline__ u32x4 pk8(const f32x4& v0, const f32x4& v1) {
  u32x4 w;
  w.x = pg8::cvt_pk_bf16(v0[0], v0[1]); w.y = pg8::cvt_pk_bf16(v0[2], v0[3]);
  w.z = pg8::cvt_pk_bf16(v1[0], v1[1]); w.w = pg8::cvt_pk_bf16(v1[2], v1[3]);
  return w;
}
struct EpiY {
  static constexpr bool PERM = true, AFTER_DRAIN = false;
  bf16_t* O; int ldc;
  __device__ __forceinline__ void operator()(const f32x4 (&acc)[2][2][4][2], const pg8::Unit& u, int wr, int wc, int fr, int fq) const {
    const int row0 = u.pm * 256 + wr * 64 + fr, col0 = u.pn * 256 + wc * 32 + 8 * fq;
#pragma unroll
    for (int ai = 0; ai < 2; ++ai)
#pragma unroll
      for (int m = 0; m < 4; ++m) {
        bf16_t* rowp = O + (size_t)(row0 + ai * 128 + m * 16) * ldc + col0;
#pragma unroll
        for (int bj = 0; bj < 2; ++bj) *(u32x4*)(rowp + bj * 128) = pk8(acc[ai][bj][m][0], acc[ai][bj][m][1]);
      }
  }
};
struct EpiSwiglu {
  static constexpr bool PERM = true, AFTER_DRAIN = false;
  bf16_t* O;
  __device__ __forceinline__ void operator()(const f32x4 (&acc)[2][2][4][2], const pg8::Unit& u, int wr, int wc, int fr, int fq) const {
    const int row0 = u.pm * 256 + wr * 64 + fr, col0 = u.pn * 128 + wc * 32 + 8 * fq;
#pragma unroll
    for (int ai = 0; ai < 2; ++ai)
#pragma unroll
      for (int m = 0; m < 4; ++m) {
        f32x4 v0, v1;
#pragma unroll
        for (int j = 0; j < 4; ++j) {
          v0[j] = silu_f(acc[ai][0][m][0][j]) * acc[ai][1][m][0][j];
          v1[j] = silu_f(acc[ai][0][m][1][j]) * acc[ai][1][m][1][j];
        }
        *(u32x4*)(O + (size_t)(row0 + ai * 128 + m * 16) * 2816 + col0) = pk8(v0, v1);
      }
  }
};
struct EpiFourier {
  static constexpr bool PERM = true, AFTER_DRAIN = false;
  bf16_t* mix; int lat;
  __device__ __forceinline__ void operator()(const f32x4 (&acc)[2][2][4][2], const pg8::Unit& u, int wr, int wc, int fr, int fq) const {
    const int row0 = (lat ? NCTX + u.pn * 2048 + u.pm * 256 : u.pn * 256) + wr * 64 + fr, col0 = wc * 32 + 8 * fq;
#pragma unroll
    for (int ai = 0; ai < 2; ++ai)
#pragma unroll
      for (int m = 0; m < 4; ++m) {
        bf16_t* rowp = mix + (size_t)(row0 + ai * 128 + m * 16) * 1024 + col0;
#pragma unroll
        for (int bj = 0; bj < 2; ++bj) *(u32x4*)(rowp + bj * 128) = pk8(acc[ai][bj][m][0], acc[ai][bj][m][1]);
      }
  }
};
struct EpiWin {
  static constexpr bool PERM = true, AFTER_DRAIN = false;
  int l;
  __device__ __forceinline__ void operator()(const f32x4 (&acc)[2][2][4][2], const pg8::Unit& u, int wr, int wc, int fr, int fq) const {
    char* ws = kparams().ws; float* out = kparams().out;
    if (u.pn < 2) {
      const int part = u.pn;
#pragma unroll
      for (int ai = 0; ai < 2; ++ai)
#pragma unroll
        for (int m = 0; m < 4; ++m) {
          int fro = fr; asm volatile("" : "+v"(fro));
          const int row = u.pm * 256 + ai * 128 + wr * 64 + m * 16 + fro;
          bf16_t* base; int L2;
          if (row < NCTX) { L2 = 512; base = (bf16_t*)(ws + OFF_ABC) + (size_t)(row >> 8) * 256 * 512 + part * 256 + (row & 255); }
          else { int mm = row - NCTX; L2 = 4096; base = (bf16_t*)(ws + OFF_ABL) + (size_t)(mm >> 11) * 256 * 4096 + part * 2048 + (mm & 2047); }
#pragma unroll
          for (int bj = 0; bj < 2; ++bj)
#pragma unroll
            for (int n = 0; n < 2; ++n)
#pragma unroll
              for (int j = 0; j < 4; ++j) {
                int nidx = bj * 128 + wc * 32 + 8 * fq + 4 * n + j;
                base[(size_t)nidx * L2] = (bf16_t)f2bf(acc[ai][bj][m][n][j]);
              }
        }
    } else {
      bf16_t* U = (bf16_t*)(ws + OFF_U);
#pragma unroll
      for (int ai = 0; ai < 2; ++ai)
#pragma unroll
        for (int m = 0; m < 4; ++m) {
          int fro = fr; asm volatile("" : "+v"(fro));
          const int row = u.pm * 256 + ai * 128 + wr * 64 + m * 16 + fro;
#pragma unroll
          for (int bj = 0; bj < 2; ++bj) {
            const int col = u.pn * 256 + bj * 128 + wc * 32 + 8 * fq;
            const int ucol = col - 512;
            if (ucol < LDU) {
              *(u32x4*)(U + (size_t)row * LDU + ucol) = pk8(acc[ai][bj][m][0], acc[ai][bj][m][1]);
              if (row < NCTX && col >= 1936) {
                const int b = row >> 8, t = row & 255;
                float* dst = (col < 2320) ? out + OUT_CK + ((size_t)((b * 2 + l) * 256 + t)) * 384 + (col - 1936)
                                          : out + OUT_CV + ((size_t)((b * 2 + l) * 256 + t)) * 384 + (col - 2320);
                *(f32x4*)dst = acc[ai][bj][m][0];
                *(f32x4*)(dst + 4) = acc[ai][bj][m][1];
              }
            }
          }
        }
    }
  }
};

template <int KIND>
__device__ __forceinline__ void gemm_phase_k(const Params& p, int l, int s, PG8_LAS unsigned char* lds) {
  pg8::Gemm g; pg8::StaticOrder S;
  if (KIND == 0) {
    g.A = (const bf16_t*)(p.ws + OFF_H); g.Bt = (const bf16_t*)(p.ws + OFF_WT13) + (size_t)(l * 2 + s) * 5632 * 1024; g.M = NTOK; g.N = 5632; g.K = 1024;
    S.init(g.M, g.N, (int)gridDim.x, (int)blockIdx.x);
    EpiSwiglu E; E.O = (bf16_t*)(p.ws + OFF_ACT);
    pg8::gemm_phase<EpiSwiglu, pg8::StaticOrder, false>(lds, g, S, E, nullptr);
  } else if (KIND == 1) {
    g.A = (const bf16_t*)(p.ws + OFF_ACT); g.Bt = (const bf16_t*)(p.ws + OFF_WT2) + (size_t)(l * 2 + s) * 1024 * 2816; g.M = NTOK; g.N = 1024; g.K = 2816;
    S.init(g.M, g.N, (int)gridDim.x, (int)blockIdx.x);
    EpiY E; E.O = (bf16_t*)(p.ws + OFF_Y); E.ldc = 1024;
    pg8::gemm_phase<EpiY, pg8::StaticOrder, false>(lds, g, S, E, nullptr);
  } else if (KIND == 2) {
    g.A = (const bf16_t*)(p.ws + OFF_H); g.Bt = (const bf16_t*)(p.ws + OFF_WTIN) + (size_t)l * 2816 * 1024; g.M = NTOK; g.N = 2816; g.K = 1024;
    EpiWin E; E.l = l;
    if (gridDim.x == 256) { WinOrder W; W.c = (int)blockIdx.x; pg8::gemm_phase<EpiWin, WinOrder, false>(lds, g, W, E, nullptr); }
    else { S.init(g.M, g.N, (int)gridDim.x, (int)blockIdx.x); pg8::gemm_phase<EpiWin, pg8::StaticOrder, false>(lds, g, S, E, nullptr); }
  } else {
    g.A = (const bf16_t*)(p.ws + OFF_MIX); g.Bt = (const bf16_t*)(p.ws + OFF_WTOUT) + (size_t)l * 1024 * 1024; g.M = NTOK; g.N = 1024; g.K = 1024;
    S.init(g.M, g.N, (int)gridDim.x, (int)blockIdx.x);
    EpiY E; E.O = (bf16_t*)(p.ws + OFF_Y); E.ldc = 1024;
    pg8::gemm_phase<EpiY, pg8::StaticOrder, false>(lds, g, S, E, nullptr);
  }
}

__device__ __forceinline__ void fourier_unit(const Params& p, int item, PG8_LAS unsigned char* lds) {
  pg8::Gemm g; OneUnit S; EpiFourier E; E.mix = (bf16_t*)(p.ws + OFF_MIX);
  if (item < 32) {
    g.A = (const bf16_t*)(p.ws + OFF_DFTL); g.Bt = (const bf16_t*)(p.ws + OFF_ABL); g.M = 2048; g.N = 1024; g.K = 4096;
    S.pm = item & 7; S.pn = item >> 3; E.lat = 1;
  } else {
    g.A = (const bf16_t*)(p.ws + OFF_DFTS); g.Bt = (const bf16_t*)(p.ws + OFF_ABC); g.M = 256; g.N = 8192; g.K = 512;
    S.pm = 0; S.pn = item - 32; E.lat = 0;
  }
  pg8::gemm_phase<EpiFourier, OneUnit, false>(lds, g, S, E, nullptr);
}

struct AttnCtx {
  const bf16_t* U; const bf16_t* CK; const bf16_t* CV;
  bf16_t* Qs; bf16_t* Ks; bf16_t* Vt; float* rp;
  int lat, l, b, h, r, rs, nch, tid, lane, w, g, ql, qc, cst, li, seg, dp, kg, vpos0, vpos1;
};

__device__ __forceinline__ void attn_load_chunk(const AttnCtx& c, int ci, u32x4 (&kr)[4], unsigned (&vr)[16]) {
#pragma unroll
  for (int kk = 0; kk < 2; kk++) {
    const bf16_t* kb; const bf16_t* vb; int ld;
    if (c.lat && ci >= 4) {
      const size_t base = ((size_t)((c.b * 2 + c.l) * 512 + (ci - 4) * 128 + kk * 64)) * 384 + c.h * 64;
      kb = c.CK + base; vb = c.CV + base; ld = 384;
    } else {
      const int krow0 = c.lat ? (NCTX + c.b * 2048 + (c.rs + 2 * ci + kk) * 64) : (c.b * 256 + ci * 128 + kk * 64);
      kb = c.U + (size_t)krow0 * LDU + U_K + c.h * 64; vb = c.U + (size_t)krow0 * LDU + U_V + c.h * 64; ld = LDU;
    }
    const bf16_t* kp = kb + (size_t)c.li * ld + c.seg;
    kr[kk * 2 + 0] = *(const u32x4*)kp; kr[kk * 2 + 1] = *(const u32x4*)(kp + 8);
    const bf16_t* vp = vb + (size_t)(c.kg * 8) * ld + 2 * c.dp;
#pragma unroll
    for (int i = 0; i < 8; i++) vr[kk * 8 + i] = *(const unsigned*)(vp + (size_t)i * ld);
  }
}

__device__ __forceinline__ void attn_step(const AttnCtx& c, int ci, u32x4 (&kr)[4], unsigned (&vr)[16], f32x4 (&oT)[4], float& mrow,
                                          float& lsum) {
  bf16_t* Qs = c.Qs; bf16_t* Ks = c.Ks; bf16_t* Vt = c.Vt;
  const int g = c.g, ql = c.ql, w = c.w;
  __syncthreads();
#pragma unroll
  for (int kk = 0; kk < 2; kk++) {
    *(u32x4*)(Ks + (kk * 64 + c.li) * 72 + c.seg) = kr[kk * 2 + 0];
    *(u32x4*)(Ks + (kk * 64 + c.li) * 72 + c.seg + 8) = kr[kk * 2 + 1];
    uint2 lo0, lo1, hi0, hi1;
    lo0.x = (vr[kk * 8 + 0] & 0xffffu) | (vr[kk * 8 + 1] << 16); lo0.y = (vr[kk * 8 + 2] & 0xffffu) | (vr[kk * 8 + 3] << 16);
    lo1.x = (vr[kk * 8 + 4] & 0xffffu) | (vr[kk * 8 + 5] << 16); lo1.y = (vr[kk * 8 + 6] & 0xffffu) | (vr[kk * 8 + 7] << 16);
    hi0.x = (vr[kk * 8 + 0] >> 16) | (vr[kk * 8 + 1] & 0xffff0000u); hi0.y = (vr[kk * 8 + 2] >> 16) | (vr[kk * 8 + 3] & 0xffff0000u);
    hi1.x = (vr[kk * 8 + 4] >> 16) | (vr[kk * 8 + 5] & 0xffff0000u); hi1.y = (vr[kk * 8 + 6] >> 16) | (vr[kk * 8 + 7] & 0xffff0000u);
    *(uint2*)(Vt + (2 * c.dp) * 136 + kk * 64 + c.vpos0) = lo0;
    *(uint2*)(Vt + (2 * c.dp) * 136 + kk * 64 + c.vpos1) = lo1;
    *(uint2*)(Vt + (2 * c.dp + 1) * 136 + kk * 64 + c.vpos0) = hi0;
    *(uint2*)(Vt + (2 * c.dp + 1) * 136 + kk * 64 + c.vpos1) = hi1;
  }
  __syncthreads();
  attn_load_chunk(c, min(ci + 2, c.nch - 1), kr, vr);
  f32x4 sT[8];
#pragma unroll
  for (int kt = 0; kt < 8; kt++) sT[kt] = (f32x4){0.f, 0.f, 0.f, 0.f};
#pragma unroll
  for (int ks = 0; ks < 2; ks++) {
    bf16x8 qb = *(const bf16x8*)(Qs + (16 * w + ql) * 72 + ks * 32 + g * 8);
#pragma unroll
    for (int kt = 0; kt < 8; kt++) {
      bf16x8 ka = *(const bf16x8*)(Ks + (16 * kt + ql) * 72 + ks * 32 + g * 8);
      sT[kt] = __builtin_amdgcn_mfma_f32_16x16x32_bf16(ka, qb, sT[kt], 0, 0, 0);
    }
  }
  if (c.lat && ci < 4) {
#pragma unroll
    for (int kt = 0; kt < 8; kt++)
#pragma unroll
      for (int rg = 0; rg < 4; rg++) {
        const int kc = 16 * (kt & 3) + 4 * g + rg;
        const int dr = c.rs + 2 * ci + (kt >> 2) - c.r + 7;
        const bool valid = (unsigned)(kc - c.cst) < 16u;
        const int dc = min(max(kc - c.qc + 15, 0), 30);
        const float biased = sT[kt][rg] + c.rp[dr * 31 + dc];
        sT[kt][rg] = valid ? biased : -1e30f;
      }
  }
  float mx = -1e30f;
#pragma unroll
  for (int kt = 0; kt < 8; kt++)
#pragma unroll
    for (int rg = 0; rg < 4; rg++) mx = fmaxf(mx, sT[kt][rg]);
  mx = fmaxf(mx, __shfl_xor(mx, 16, 64));
  mx = fmaxf(mx, __shfl_xor(mx, 32, 64));
  const float mnew = fmaxf(mrow, mx);
  const float alpha = __expf(mrow - mnew);
  float rsum = 0.f;
#pragma unroll
  for (int kt = 0; kt < 8; kt++)
#pragma unroll
    for (int rg = 0; rg < 4; rg++) {
      float pv = __expf(sT[kt][rg] - mnew);
      rsum += pv;
      sT[kt][rg] = pv;
    }
  rsum += __shfl_xor(rsum, 16, 64);
  rsum += __shfl_xor(rsum, 32, 64);
  lsum = lsum * alpha + rsum;
  mrow = mnew;
#pragma unroll
  for (int dt = 0; dt < 4; dt++) oT[dt] *= alpha;
#pragma unroll
  for (int kb = 0; kb < 4; kb++) {
    uint4 pk;
    pk.x = pack2(sT[2 * kb][0], sT[2 * kb][1]); pk.y = pack2(sT[2 * kb][2], sT[2 * kb][3]);
    pk.z = pack2(sT[2 * kb + 1][0], sT[2 * kb + 1][1]); pk.w = pack2(sT[2 * kb + 1][2], sT[2 * kb + 1][3]);
    const bf16x8 pb = as_frag(pk);
#pragma unroll
    for (int dt = 0; dt < 4; dt++) {
      bf16x8 va = *(const bf16x8*)(Vt + (16 * dt + ql) * 136 + kb * 32 + g * 8);
      oT[dt] = __builtin_amdgcn_mfma_f32_16x16x32_bf16(va, pb, oT[dt], 0, 0, 0);
    }
  }
}

__device__ __forceinline__ void attn_tile(const Params& p, int l, int item, char* smem) {
  AttnCtx c;
  c.Qs = (bf16_t*)smem;
  c.Ks = c.Qs + 64 * 72;
  c.Vt = c.Ks + 128 * 72;
  c.rp = (float*)(c.Vt + 64 * 136);
  c.U = (const bf16_t*)(p.ws + OFF_U); c.CK = (const bf16_t*)(p.ws + OFF_CK16); c.CV = (const bf16_t*)(p.ws + OFF_CV16);
  c.tid = otid4(); c.lane = c.tid & 63; c.w = c.tid >> 6; c.g = c.lane >> 4; c.ql = c.lane & 15; c.l = l;
  int rowq;
  if (item < 768) { c.lat = 1; c.b = item / 192; c.h = (item / 32) % 6; c.r = item & 31; c.rs = min(max(c.r - 4, 0), 24); rowq = NCTX + c.b * 2048 + c.r * 64; c.nch = 8; }
  else { int it = item - 768; c.lat = 0; c.b = it / 24; c.h = (it >> 2) % 6; int qb = it & 3; c.r = 0; c.rs = 0; rowq = c.b * 256 + qb * 64; c.nch = 2; }
  c.li = c.tid >> 2; c.seg = (c.tid & 3) * 16; c.dp = c.tid & 31; c.kg = c.tid >> 5;
  c.vpos0 = 32 * (c.kg >> 2) + 8 * ((2 * c.kg) & 3) + 4 * ((c.kg >> 1) & 1);
  c.vpos1 = 32 * (c.kg >> 2) + 8 * ((2 * c.kg + 1) & 3) + 4 * ((c.kg >> 1) & 1);
  c.qc = 16 * c.w + c.ql;
  c.cst = min(max(c.qc - 8, 0), 48);
  u32x4 krA[4], krB[4]; unsigned vrA[16], vrB[16];
  attn_load_chunk(c, 0, krA, vrA);
  attn_load_chunk(c, 1, krB, vrB);
  __syncthreads();
  {
    const bf16_t* qp = c.U + (size_t)(rowq + c.li) * LDU + U_Q + c.h * 64 + c.seg;
    uint4 q0 = *(const uint4*)qp, q1 = *(const uint4*)(qp + 8);
    float f[8];
    unpack8(q0, f);
#pragma unroll
    for (int e = 0; e < 8; e++) f[e] *= 0.125f;
    *(uint4*)(c.Qs + c.li * 72 + c.seg) = pack8(f);
    unpack8(q1, f);
#pragma unroll
    for (int e = 0; e < 8; e++) f[e] *= 0.125f;
    *(uint4*)(c.Qs + c.li * 72 + c.seg + 8) = pack8(f);
    if (c.lat)
      for (int i = c.tid; i < 465; i += 256) c.rp[i] = p.rpb[(size_t)(l * 6 + c.h) * 465 + i];
  }
  float mrow = -1e30f, lsum = 0.f;
  f32x4 oT[4];
#pragma unroll
  for (int i = 0; i < 4; i++) oT[i] = (f32x4){0.f, 0.f, 0.f, 0.f};
#pragma unroll 1
  for (int ci = 0; ci < c.nch; ci += 2) {
    attn_step(c, ci, krA, vrA, oT, mrow, lsum);
    attn_step(c, ci + 1, krB, vrB, oT, mrow, lsum);
  }
  bf16_t* mix = (bf16_t*)(p.ws + OFF_MIX);
  const float inv = 1.f / lsum;
  const int row = rowq + 16 * c.w + c.ql;
#pragma unroll
  for (int dt = 0; dt < 4; dt++) {
    uint2 o;
    o.x = pack2(oT[dt][0] * inv, oT[dt][1] * inv);
    o.y = pack2(oT[dt][2] * inv, oT[dt][3] * inv);
    *(uint2*)(mix + (size_t)row * 1024 + 640 + c.h * 64 + 16 * dt + 4 * c.g) = o;
  }
}

__device__ __forceinline__ void conv8(const bf16_t* __restrict__ U, const float* __restrict__ cw,
                                      const float* __restrict__ cb, int rowbase, int L, int tc, int ch, float (&o)[8]) {
  float4 b0 = *(const float4*)(cb + ch), b1 = *(const float4*)(cb + ch + 4);
  o[0] = b0.x; o[1] = b0.y; o[2] = b0.z; o[3] = b0.w; o[4] = b1.x; o[5] = b1.y; o[6] = b1.z; o[7] = b1.w;
#pragma unroll
  for (int j = 0; j < 5; j++) {
    int tt = tc + j - 2;
    if (tt >= 0 && tt < L) {
      uint4 raw = *(const uint4*)(U + (size_t)(rowbase + tt) * LDU + U_XBC + ch);
      float f[8];
      unpack8(raw, f);
      float4 w0 = *(const float4*)(cw + j * 640 + ch), w1 = *(const float4*)(cw + j * 640 + ch + 4);
      o[0] += w0.x * f[0]; o[1] += w0.y * f[1]; o[2] += w0.z * f[2]; o[3] += w0.w * f[3];
      o[4] += w1.x * f[4]; o[5] += w1.y * f[5]; o[6] += w1.z * f[6]; o[7] += w1.w * f[7];
    }
  }
#pragma unroll
  for (int e = 0; e < 8; e++) o[e] = silu_f(o[e]);
}

struct SsdSm {
  bf16_t* xT;
  bf16_t* Bn;
  bf16_t* Cn;
  bf16_t* BT;
  float* dts;
  float* cs;
  float* wts;
  float* G;
};
__device__ __forceinline__ SsdSm ssd_carve(char* smem) {
  SsdSm s;
  s.xT = (bf16_t*)smem;
  s.Bn = s.xT + 192 * 72;
  s.Cn = s.Bn + 64 * 72;
  s.dts = (float*)(s.Cn + 64 * 72);
  s.cs = s.dts + 384;
  s.wts = s.cs + 384;
  s.BT = (bf16_t*)(s.wts + 384);
  s.G = s.wts + 384;
  return s;
}

__device__ __forceinline__ u32x4 ld_row(const bf16_t* __restrict__ U, int rowbase, int L, int tt, int chcol) {
  const int tc = min(max(tt, 0), L - 1);
  return *(const u32x4*)(U + (size_t)(rowbase + tc) * LDU + U_XBC + chcol);
}
__device__ __forceinline__ void unpack8v(u32x4 r, float m, float (&f)[8]) {
  f[0] = __uint_as_float(r.x << 16) * m; f[1] = __uint_as_float(r.x & 0xffff0000u) * m;
  f[2] = __uint_as_float(r.y << 16) * m; f[3] = __uint_as_float(r.y & 0xffff0000u) * m;
  f[4] = __uint_as_float(r.z << 16) * m; f[5] = __uint_as_float(r.z & 0xffff0000u) * m;
  f[6] = __uint_as_float(r.w << 16) * m; f[7] = __uint_as_float(r.w & 0xffff0000u) * m;
}
template <int NT>
__device__ __forceinline__ void conv_block(const bf16_t* __restrict__ U, const float* __restrict__ cw, const float* __restrict__ cb,
                                           int rowbase, int L, int tfirst, int ch, float (&o)[NT][8]) {
  u32x4 raw[NT + 4];
#pragma unroll
  for (int i = 0; i < NT + 4; i++) raw[i] = ld_row(U, rowbase, L, tfirst + i - 2, ch);
  float4 w0[5], w1[5];
#pragma unroll
  for (int j = 0; j < 5; j++) { w0[j] = *(const float4*)(cw + j * 640 + ch); w1[j] = *(const float4*)(cw + j * 640 + ch + 4); }
  const float4 b0 = *(const float4*)(cb + ch), b1 = *(const float4*)(cb + ch + 4);
#pragma unroll
  for (int i = 0; i < NT; i++) { o[i][0] = b0.x; o[i][1] = b0.y; o[i][2] = b0.z; o[i][3] = b0.w; o[i][4] = b1.x; o[i][5] = b1.y; o[i][6] = b1.z; o[i][7] = b1.w; }
#pragma unroll
  for (int rI = 0; rI < NT + 4; rI++) {
    const int tt = tfirst + rI - 2;
    const float m = (tt >= 0 && tt < L) ? 1.f : 0.f;
    float f[8];
    unpack8v(raw[rI], m, f);
#pragma unroll
    for (int j = 0; j < 5; j++) {
      const int i = rI - j;
      if (i >= 0 && i < NT) {
        o[i][0] += w0[j].x * f[0]; o[i][1] += w0[j].y * f[1]; o[i][2] += w0[j].z * f[2]; o[i][3] += w0[j].w * f[3];
        o[i][4] += w1[j].x * f[4]; o[i][5] += w1[j].y * f[5]; o[i][6] += w1[j].z * f[6]; o[i][7] += w1[j].w * f[7];
      }
    }
  }
#pragma unroll
  for (int i = 0; i < NT; i++)
#pragma unroll
    for (int e = 0; e < 8; e++) o[i][e] = silu_f(o[i][e]);
}

__device__ __forceinline__ void ssd_load(const Params& p, int l, int rowbase, int L, int t0, int g, bool rope, bool needBT,
                         const SsdSm& s) {
  const bf16_t* U = (const bf16_t*)(p.ws + OFF_U);
  const float* cw = p.conv_w + (size_t)l * 5 * 640;
  const float* cb = p.conv_b + (size_t)l * 640;
  const int tid = otid4(), lane = tid & 63, w = tid >> 6;
  __syncthreads();
#pragma unroll 1
  for (int rnd = 0; rnd < 2; rnd++) {
    const int unit = rnd * 256 + tid;
    if (unit < 384) {
      const int cbk = unit % 24, tg = unit / 24;
      float o[4][8];
      conv_block<4>(U, cw, cb, rowbase, L, t0 + 4 * tg, 192 * g + cbk * 8, o);
#pragma unroll
      for (int e = 0; e < 8; e++) {
        uint2 pk;
        pk.x = pack2(o[0][e], o[1][e]); pk.y = pack2(o[2][e], o[3][e]);
        *(uint2*)(s.xT + (cbk * 8 + e) * 72 + 4 * tg) = pk;
      }
    } else {
      const int t128 = unit - 384;
      float raw[3];
#pragma unroll
      for (int k = 0; k < 3; k++) {
        const int i = t128 + 128 * k, t = i / 6, hh = i % 6;
        const int dir = hh / 3, h3 = hh % 3, hd = 3 * g + h3;
        raw[k] = bf2f(U[(size_t)(rowbase + t0 + t) * LDU + U_DT + dir * 6 + hd]) + p.dt_bias[(l * 2 + dir) * 6 + hd];
      }
#pragma unroll
      for (int k = 0; k < 3; k++) {
        const int i = t128 + 128 * k, t = i / 6, hh = i % 6;
        const int dir = hh / 3, h3 = hh % 3;
        s.dts[(dir * 3 + h3) * 64 + t] = raw[k] > 20.f ? raw[k] : log1pf(__expf(raw[k]));
      }
    }
  }
  {
    const int t2 = tid >> 3, which = (tid >> 2) & 1, pb = tid & 3;
    const int q = (pb & 1) * 8 + (pb >> 1) * 32;
    const int chb = 384 + which * 128 + g * 64;
    bf16_t* arr = which ? s.Cn : s.Bn;
    int two = 2;
    asm volatile("" : "+s"(two));
#pragma unroll 1
    for (int hv = 0; hv < two; hv++) {
      float o[2][8];
      conv_block<2>(U, cw, cb, rowbase, L, t0 + 2 * t2, chb + q + 16 * hv, o);
      *(uint4*)(arr + (2 * t2) * 72 + q + 16 * hv) = pack8(o[0]);
      *(uint4*)(arr + (2 * t2 + 1) * 72 + q + 16 * hv) = pack8(o[1]);
    }
    if (rope || (which == 0 && needBT)) {
#pragma unroll 1
      for (int i = 0; i < two; i++) {
        const int t = 2 * t2 + i;
        float v1[8], v2[8];
        unpack8(*(const uint4*)(arr + t * 72 + q), v1);
        unpack8(*(const uint4*)(arr + t * 72 + q + 16), v2);
        if (rope) {
          const int tabs = t0 + t;
          const int pos = (q < 32) ? (tabs >> 6) : (tabs & 63);
          const float4* rt = (const float4*)(p.ws + OFF_ROPE) + (pos * 16 + (q & 15)) / 2;
          const float4 r0 = rt[0], r1 = rt[1], r2 = rt[2], r3 = rt[3];
          const float cs_[8] = {r0.x, r0.z, r1.x, r1.z, r2.x, r2.z, r3.x, r3.z};
          const float sn_[8] = {r0.y, r0.w, r1.y, r1.w, r2.y, r2.w, r3.y, r3.w};
#pragma unroll
          for (int e = 0; e < 8; e++) {
            const float a = v1[e], bb = v2[e];
            v1[e] = a * cs_[e] - bb * sn_[e];
            v2[e] = a * sn_[e] + bb * cs_[e];
          }
          *(uint4*)(arr + t * 72 + q) = pack8(v1);
          *(uint4*)(arr + t * 72 + q + 16) = pack8(v2);
        }
        if (which == 0 && needBT) {
#pragma unroll
          for (int e = 0; e < 8; e++) {
            s.BT[(q + e) * 72 + t] = (bf16_t)f2bf(v1[e]);
            s.BT[(q + 16 + e) * 72 + t] = (bf16_t)f2bf(v2[e]);
          }
        }
      }
    }
  }
  __syncthreads();
  for (int sq = w; sq < 6; sq += 4) {
    int dir = sq / 3, h3 = sq % 3;
    float a = -__expf(p.a_log[(l * 2 + dir) * 6 + 3 * g + h3]);
    int t = dir ? 63 - lane : lane;
    float v = s.dts[sq * 64 + t] * a;
#pragma unroll
    for (int o = 1; o < 64; o <<= 1) {
      float n = __shfl_up(v, o, 64);
      if (lane >= o) v += n;
    }
    s.cs[sq * 64 + t] = v;
  }
  __syncthreads();
}

__device__ __forceinline__ void ssd_state_tile(const Params& p, int l, int item, char* smem) {
  SsdSm s = ssd_carve(smem);
  const int tid = otid4(), lane = tid & 63, w = tid >> 6;
  bool lat; int sq, c, g, NC, L, rowbase; float* S; float* dec;
  if (item < 256) { lat = true; sq = item >> 6; c = (item >> 1) & 31; g = item & 1; NC = 32; L = 2048; rowbase = NCTX + sq * 2048; S = (float*)(p.ws + OFF_SL); dec = (float*)(p.ws + OFF_DL); }
  else { int it = item - 256; lat = false; sq = it >> 3; c = (it >> 1) & 3; g = it & 1; NC = 4; L = 256; rowbase = sq * 256; S = (float*)(p.ws + OFF_SC); dec = (float*)(p.ws + OFF_DC); }
  ssd_load(p, l, rowbase, L, c * 64, g, lat, true, s);
  for (int i = tid; i < 384; i += 256) {
    int q = i >> 6, t = i & 63;
    int dir = q / 3;
    float ce = dir ? s.cs[q * 64 + 0] : s.cs[q * 64 + 63];
    s.wts[i] = __expf(ce - s.cs[i]) * s.dts[i];
  }
  __syncthreads();
#pragma unroll 1
  for (int q = 0; q < 6; q++) {
    const int dir = q / 3, h3 = q % 3;
    f32x4 acc[4];
#pragma unroll
    for (int nt = 0; nt < 4; nt++) acc[nt] = (f32x4){0.f, 0.f, 0.f, 0.f};
#pragma unroll
    for (int ks = 0; ks < 2; ks++) {
      const int tb = ks * 32 + (lane >> 4) * 8;
      uint4 raw = *(const uint4*)(s.xT + (h3 * 64 + 16 * w + (lane & 15)) * 72 + tb);
      float f[8];
      unpack8(raw, f);
#pragma unroll
      for (int e = 0; e < 8; e++) f[e] *= s.wts[q * 64 + tb + e];
      bf16x8 a = as_frag(pack8(f));
#pragma unroll
      for (int nt = 0; nt < 4; nt++) {
        bf16x8 bb = *(const bf16x8*)(s.BT + (16 * nt + (lane & 15)) * 72 + tb);
        acc[nt] = __builtin_amdgcn_mfma_f32_16x16x32_bf16(bb, a, acc[nt], 0, 0, 0);
      }
    }
    const size_t idx = ((size_t)(sq * NC + c) * 6 + 3 * g + h3) * 2 + dir;
    float* So = S + idx * 4096;
#pragma unroll
    for (int nt = 0; nt < 4; nt++) *(f32x4*)(So + (16 * w + (lane & 15)) * 64 + 16 * nt + 4 * (lane >> 4)) = acc[nt];
    if (tid == 0) dec[idx] = __expf(dir ? s.cs[q * 64 + 0] : s.cs[q * 64 + 63]);
  }
}

__device__ __forceinline__ void ssd_prefix(const Params& p, int l) {
  const int gt = blockIdx.x * 512 + otid(), nthr = gridDim.x * 512;
  {
    const float* S = (const float*)(p.ws + OFF_SC);
    bf16_t* P16 = (bf16_t*)(p.ws + OFF_P16C);
    const float* dec = (const float*)(p.ws + OFF_DC);
    const int total = 32 * 12 * 4096;
    const bool even12 = (12 * nthr == total);
    const bool light = even12 && gt < (nthr >> 1), heavy = even12 && gt >= (nthr >> 1);
    for (int e0 = gt; e0 < total; e0 += 12 * nthr) {
      float sv[13][4], dv[13][4];
      int ev[13];
#pragma unroll
      for (int j = 0; j < 13; j++) {
        int e = e0 + j * nthr;
        if (j == 11 && light) e = total;
        if (j == 12) e = heavy ? (gt - (nthr >> 1)) + 11 * nthr : total;
        ev[j] = e;
        const int ec = min(e, total - 1);
        const int pn = ec & 4095, r = ec >> 12, dir = r & 1, h = (r >> 1) % 6, sq = r / 12;
#pragma unroll
        for (int ci = 0; ci < 4; ci++) {
          const int c = dir ? 3 - ci : ci;
          const size_t ix = ((size_t)(sq * 4 + c) * 6 + h) * 2 + dir;
          sv[j][ci] = S[ix * 4096 + pn];
          dv[j][ci] = dec[ix];
        }
      }
#pragma unroll
      for (int j = 0; j < 13; j++) {
        const int e = ev[j];
        if (e < total) {
          const int pn = e & 4095, r = e >> 12, dir = r & 1, h = (r >> 1) % 6, sq = r / 12;
          float run = 0.f;
#pragma unroll
          for (int ci = 0; ci < 4; ci++) {
            const int c = dir ? 3 - ci : ci;
            const size_t ix = ((size_t)(sq * 4 + c) * 6 + h) * 2 + dir;
            P16[ix * 4096 + pn] = (bf16_t)f2bf(run);
            run = run * dv[j][ci] + sv[j][ci];
          }
          p.out[(dir ? OUT_SB : OUT_SF) + ((size_t)(sq * 2 + l) * 6 + h) * 4096 + pn] = run;
        }
      }
    }
  }
  {
    const float* S = (const float*)(p.ws + OFF_SL);
    bf16_t* P16 = (bf16_t*)(p.ws + OFF_P16L);
    const float* dec = (const float*)(p.ws + OFF_DL);
    const int total = 4 * 12 * 4096;
    for (int e = gt; e < total; e += nthr) {
      const int pn = e & 4095, r = e >> 12, dir = r & 1, h = (r >> 1) % 6, sq = r / 12;
      float run = (dir ? p.st_b : p.st_f)[((size_t)(sq * 2 + l) * 6 + h) * 4096 + pn];
      float sv[32], dv[32];
#pragma unroll
      for (int ci = 0; ci < 32; ci++) {
        const int c = dir ? 31 - ci : ci;
        const size_t ix = ((size_t)(sq * 32 + c) * 6 + h) * 2 + dir;
        sv[ci] = S[ix * 4096 + pn];
        dv[ci] = dec[ix];
      }
#pragma unroll
      for (int ci = 0; ci < 32; ci++) {
        const int c = dir ? 31 - ci : ci;
        const size_t ix = ((size_t)(sq * 32 + c) * 6 + h) * 2 + dir;
        P16[ix * 4096 + pn] = (bf16_t)f2bf(run);
        run = run * dv[ci] + sv[ci];
      }
    }
  }
}

__device__ __forceinline__ void ssd_ld_prev(const bf16_t* __restrict__ P16, size_t idx, int lane, u32x4 (&pf)[8]) {
  const bf16_t* pv = P16 + idx * 4096;
#pragma unroll
  for (int ks = 0; ks < 2; ks++)
#pragma unroll
    for (int pt = 0; pt < 4; pt++) pf[ks * 4 + pt] = *(const u32x4*)(pv + (16 * pt + (lane & 15)) * 64 + ks * 32 + (lane >> 4) * 8);
}

__device__ __forceinline__ void ssd_out_tile(const Params& p, int l, int item, char* smem) {
  SsdSm s = ssd_carve(smem);
  float* G = s.G;
  const bf16_t* U = (const bf16_t*)(p.ws + OFF_U);
  bf16_t* mix = (bf16_t*)(p.ws + OFF_MIX);
  const int tid = otid4(), lane = tid & 63, w = tid >> 6;
  bool lat; int sq, c, g, NC, L, rowbase; const bf16_t* P16;
  if (item < 256) { lat = true; sq = item >> 6; c = (item >> 1) & 31; g = item & 1; NC = 32; L = 2048; rowbase = NCTX + sq * 2048; P16 = (const bf16_t*)(p.ws + OFF_P16L); }
  else { int it = item - 256; lat = false; sq = it >> 3; c = (it >> 1) & 3; g = it & 1; NC = 4; L = 256; rowbase = sq * 256; P16 = (const bf16_t*)(p.ws + OFF_P16C); }
  const int t0 = c * 64;
  const size_t idx0 = ((size_t)(sq * NC + c) * 6 + 3 * g) * 2;
  ssd_load(p, l, rowbase, L, t0, g, lat, false, s);
  u32x4 pfA[8], pfB[8];
  ssd_ld_prev(P16, idx0 + 0, lane, pfA);
  ssd_ld_prev(P16, idx0 + 1, lane, pfB);
  bf16x8 cfrag[2];
#pragma unroll
  for (int ks = 0; ks < 2; ks++) cfrag[ks] = *(const bf16x8*)(s.Cn + (16 * w + (lane & 15)) * 72 + ks * 32 + (lane >> 4) * 8);
  {
    f32x4 gacc[4];
#pragma unroll
    for (int st = 0; st < 4; st++) gacc[st] = (f32x4){0.f, 0.f, 0.f, 0.f};
#pragma unroll
    for (int ks = 0; ks < 2; ks++)
#pragma unroll
      for (int st = 0; st < 4; st++) {
        bf16x8 bb = *(const bf16x8*)(s.Bn + (16 * st + (lane & 15)) * 72 + ks * 32 + (lane >> 4) * 8);
        gacc[st] = __builtin_amdgcn_mfma_f32_16x16x32_bf16(cfrag[ks], bb, gacc[st], 0, 0, 0);
      }
#pragma unroll
    for (int st = 0; st < 4; st++)
#pragma unroll
      for (int rg = 0; rg < 4; rg++) G[(16 * w + 4 * (lane >> 4) + rg) * 68 + 16 * st + (lane & 15)] = gacc[st][rg];
  }
  __syncthreads();
  float ss[4] = {0.f, 0.f, 0.f, 0.f};
  const int lrow = 16 * w + (lane & 15);
#pragma unroll
  for (int h3 = 0; h3 < 3; h3++) {
    const float* csf = s.cs + h3 * 64; const float* csb = s.cs + (3 + h3) * 64;
    const float* dtf = s.dts + h3 * 64; const float* dtb = s.dts + (3 + h3) * 64;
    f32x4 acc[4];
#pragma unroll
    for (int pt = 0; pt < 4; pt++) acc[pt] = (f32x4){0.f, 0.f, 0.f, 0.f};
    bf16_t zr[16];
#pragma unroll
    for (int pt = 0; pt < 4; pt++)
#pragma unroll
      for (int rg = 0; rg < 4; rg++)
        zr[pt * 4 + rg] = U[(size_t)(rowbase + t0 + 16 * w + 4 * (lane >> 4) + rg) * LDU + U_Z + (3 * g + h3) * 64 + 16 * pt + (lane & 15)];
    const float cfl = csf[lrow], cbl = csb[lrow];
#pragma unroll
    for (int ks = 0; ks < 2; ks++) {
      const int sb = ks * 32 + (lane >> 4) * 8;
      float f[8];
#pragma unroll
      for (int e = 0; e < 8; e++) {
        int sx = sb + e;
        float gv = G[lrow * 68 + sx];
        float mf = (sx <= lrow) ? __expf(fminf(cfl - csf[sx], 0.f)) * dtf[sx] : 0.f;
        float mb = (sx >= lrow) ? __expf(fminf(cbl - csb[sx], 0.f)) * dtb[sx] : 0.f;
        f[e] = gv * (mf + mb);
      }
      bf16x8 a = as_frag(pack8(f));
#pragma unroll
      for (int pt = 0; pt < 4; pt++) {
        bf16x8 bb = *(const bf16x8*)(s.xT + (h3 * 64 + 16 * pt + (lane & 15)) * 72 + sb);
        acc[pt] = __builtin_amdgcn_mfma_f32_16x16x32_bf16(a, bb, acc[pt], 0, 0, 0);
      }
    }
    const size_t idxn = idx0 + (size_t)(h3 < 2 ? h3 + 1 : 2) * 2;
    {
      f32x4 tacc[4];
#pragma unroll
      for (int pt = 0; pt < 4; pt++) tacc[pt] = (f32x4){0.f, 0.f, 0.f, 0.f};
#pragma unroll
      for (int ks = 0; ks < 2; ks++)
#pragma unroll
        for (int pt = 0; pt < 4; pt++)
          tacc[pt] = __builtin_amdgcn_mfma_f32_16x16x32_bf16(cfrag[ks], __builtin_bit_cast(bf16x8, pfA[ks * 4 + pt]), tacc[pt], 0, 0, 0);
      ssd_ld_prev(P16, idxn + 0, lane, pfA);
#pragma unroll
      for (int rg = 0; rg < 4; rg++) {
        float e = __expf(csf[16 * w + 4 * (lane >> 4) + rg]);
#pragma unroll
        for (int pt = 0; pt < 4; pt++) acc[pt][rg] += e * tacc[pt][rg];
      }
    }
    {
      f32x4 tacc[4];
#pragma unroll
      for (int pt = 0; pt < 4; pt++) tacc[pt] = (f32x4){0.f, 0.f, 0.f, 0.f};
#pragma unroll
      for (int ks = 0; ks < 2; ks++)
#pragma unroll
        for (int pt = 0; pt < 4; pt++)
          tacc[pt] = __builtin_amdgcn_mfma_f32_16x16x32_bf16(cfrag[ks], __builtin_bit_cast(bf16x8, pfB[ks * 4 + pt]), tacc[pt], 0, 0, 0);
      ssd_ld_prev(P16, idxn + 1, lane, pfB);
#pragma unroll
      for (int rg = 0; rg < 4; rg++) {
        float e = __expf(csb[16 * w + 4 * (lane >> 4) + rg]);
#pragma unroll
        for (int pt = 0; pt < 4; pt++) acc[pt][rg] += e * tacc[pt][rg];
      }
    }
    __syncthreads();
    const int hd = 3 * g + h3;
    const float Dh = p.ssd_d[l * 6 + hd];
#pragma unroll
    for (int pt = 0; pt < 4; pt++)
#pragma unroll
      for (int rg = 0; rg < 4; rg++) {
        int lr = 16 * w + 4 * (lane >> 4) + rg;
        int pch = 16 * pt + (lane & 15);
        float xv = bf2f(s.xT[(h3 * 64 + pch) * 72 + lr]);
        float yy = acc[pt][rg] + xv * Dh;
        float z = bf2f(zr[pt * 4 + rg]);
        yy *= silu_f(z);
        ss[rg] += yy * yy;
        s.xT[(h3 * 64 + pch) * 72 + lr] = (bf16_t)f2bf(yy);
      }
  }
  float nwt[3][4];
#pragma unroll
  for (int h3 = 0; h3 < 3; h3++)
#pragma unroll
    for (int pt = 0; pt < 4; pt++) nwt[h3][pt] = p.ssd_norm[l * 384 + (3 * g + h3) * 64 + 16 * pt + (lane & 15)];
#pragma unroll
  for (int rg = 0; rg < 4; rg++) {
    float tot = grp16_sum(ss[rg]);
    float rstd = rsqrtf(tot * (1.f / 192.f) + 1e-6f);
    int lr = 16 * w + 4 * (lane >> 4) + rg;
#pragma unroll
    for (int h3 = 0; h3 < 3; h3++)
#pragma unroll
      for (int pt = 0; pt < 4; pt++) {
        int pch = 16 * pt + (lane & 15);
        int ch = (3 * g + h3) * 64 + pch;
        float yy = bf2f(s.xT[(h3 * 64 + pch) * 72 + lr]);
        mix[(size_t)(rowbase + t0 + lr) * 1024 + 256 + ch] = (bf16_t)f2bf(yy * rstd * nwt[h3][pt]);
      }
  }
}

#define XB_TMO      128
#define XB_XCNT(j)  (256  + 64 * (j))
#define XB_XSUB(j)  (1280 + 64 * (j))
#define XB_XGEN(j)  (2304 + 64 * (j))
#define XB_TOP      3328
#define XB_TOPGEN   3392
#define XCD_BAR_WORDS 3456
#define XB_SPIN_CAP (1u << 18)
#define LAS __attribute__((address_space(3)))

__device__ __forceinline__ unsigned xb_ld(unsigned* p)              { return __hip_atomic_load(p, __ATOMIC_RELAXED, __HIP_MEMORY_SCOPE_AGENT); }
__device__ __forceinline__ unsigned xb_add(unsigned* p, unsigned v) { return __hip_atomic_fetch_add(p, v, __ATOMIC_RELAXED, __HIP_MEMORY_SCOPE_AGENT); }
__device__ __forceinline__ unsigned xb_xcc_id() { return (unsigned)__builtin_amdgcn_s_getreg((3 << 11) | 20) & 0xFu; }
#define XB_SPIN(cond, bar) do { unsigned _sp = 0; while (cond) { __builtin_amdgcn_s_sleep(1); \
    if ((++_sp & 255u) == 0u) { if (xb_ld(&(bar)[XB_TMO])) break; if (_sp > XB_SPIN_CAP) { atomicAdd(&(bar)[XB_TMO], 1u); break; } } } } while (0)

struct XcdBarrier {
    unsigned* bar; unsigned x;
    volatile LAS unsigned* st;
};

__device__ __forceinline__ XcdBarrier xcd_barrier_post(unsigned* bar, volatile LAS unsigned* st) {
    XcdBarrier b; b.bar = bar; b.x = xb_xcc_id(); b.st = st;
    if (otid() == 0) (void)xb_add(&bar[XB_XCNT(b.x)], 1u);
    return b;
}
__device__ __forceinline__ void xcd_barrier_complete(unsigned* bar, unsigned x, unsigned& nloc, unsigned& nx) {
    const unsigned G = gridDim.x * gridDim.y * gridDim.z;
    unsigned sum, cnt, mine, sp = 0u;
    for (;;) {
        sum = 0u; cnt = 0u; mine = 0u;
#pragma unroll
        for (unsigned j = 0; j < 16; ++j) { const unsigned c = xb_ld(&bar[XB_XCNT(j)]); sum += c; cnt += (c > 0u) ? 1u : 0u; mine = (j == x) ? c : mine; }
        if (sum == G) break;
        __builtin_amdgcn_s_sleep(1);
        if ((++sp & 255u) == 0u) { if (xb_ld(&bar[XB_TMO])) break; if (sp > XB_SPIN_CAP) { atomicAdd(&bar[XB_TMO], 1u); break; } }
    }
    nloc = mine > 0u ? mine : 1u; nx = cnt > 0u ? cnt : 1u;
}

__device__ __forceinline__ void xcd_barrier(const XcdBarrier& b) {
    asm volatile("s_waitcnt vmcnt(0)" ::: "memory");
    __syncthreads();
    if (otid() == 0) {
        unsigned* bar = b.bar;
        __builtin_amdgcn_s_waitcnt(0);
        unsigned nloc = b.st[0], nx = b.st[1];
        if (nloc == 0u) { xcd_barrier_complete(bar, b.x, nloc, nx); b.st[0] = nloc; b.st[1] = nx; }
        const unsigned old = xb_add(&bar[XB_XSUB(b.x)], 1u);
        const unsigned gen = old / nloc;
        if (old + 1u == (gen + 1u) * nloc) {
            __builtin_amdgcn_fence(__ATOMIC_RELEASE, "agent");
            asm volatile("s_waitcnt vmcnt(0)" ::: "memory");
            const unsigned og = xb_add(&bar[XB_TOP], 1u);
            const unsigned tg = og / nx;
            if (og + 1u == (tg + 1u) * nx) xb_add(&bar[XB_TOPGEN], 1u);
            else XB_SPIN(xb_ld(&bar[XB_TOPGEN]) == tg, bar);
            __builtin_amdgcn_fence(__ATOMIC_ACQUIRE, "agent");
            xb_add(&bar[XB_XGEN(b.x)], 1u);
            asm volatile("s_waitcnt vmcnt(0)" ::: "memory");
        } else {
            XB_SPIN(xb_ld(&bar[XB_XGEN(b.x)]) == gen, bar);
            __builtin_amdgcn_fence(__ATOMIC_ACQUIRE, "agent");
            asm volatile("s_waitcnt vmcnt(0)" ::: "memory");
        }
    }
    __syncthreads();
}

__device__ __forceinline__ void gsync(unsigned* ctr, unsigned& nb) {
  asm volatile("s_waitcnt vmcnt(0) lgkmcnt(0)" ::: "memory");
  __syncthreads();
  nb += gridDim.x;
  if (threadIdx.x == 0) {
    __builtin_amdgcn_fence(__ATOMIC_RELEASE, "agent");
    asm volatile("s_waitcnt vmcnt(0)" ::: "memory");
    __hip_atomic_fetch_add(ctr, 1u, __ATOMIC_RELAXED, __HIP_MEMORY_SCOPE_AGENT);
    while (__hip_atomic_load(ctr, __ATOMIC_RELAXED, __HIP_MEMORY_SCOPE_AGENT) < nb) __builtin_amdgcn_s_sleep(2);
    __builtin_amdgcn_fence(__ATOMIC_ACQUIRE, "agent");
    asm volatile("s_waitcnt vmcnt(0)" ::: "memory");
  }
  __syncthreads();
}

#ifndef REP_FL
#define REP_FL 1
#endif
#ifndef REP_SS
#define REP_SS 1
#endif
#ifndef REP_AL
#define REP_AL 1
#endif
#ifndef REP_AC
#define REP_AC 1
#endif
#ifndef REP_PF
#define REP_PF 1
#endif
#ifndef REP_G
#define REP_G 1
#endif
#ifndef REP_MA
#define REP_MA 1
#endif
#ifndef REP_SO
#define REP_SO 1
#endif
#ifndef REP_P0
#define REP_P0 1
#endif
template <int l>
__device__ __forceinline__ void layer_body(const XcdBarrier& xb, char* smem, PG8_LAS unsigned char* lds, unsigned long long& span_acc) {
  unsigned long long span_t0 = 0;
    for (int rep = 0; rep < REP_G; rep++) { SPAN_B(2); gemm_phase_k<0>(kparams(), l, 0, lds); SPAN_E(2); SPAN_B(1); xcd_barrier(xb); SPAN_E(1); }
    for (int rep = 0; rep < REP_G; rep++) { SPAN_B(3); gemm_phase_k<1>(kparams(), l, 0, lds); SPAN_E(3); SPAN_B(1); xcd_barrier(xb); SPAN_E(1); }
    SPAN_B(6);
    rowpass(kparams(), l != 0, false, true, l, 2,
            kparams().norm_post + (l * 3 + 0) * 1024, 0.5f, true, l, 3, kparams().norm_pre + (l * 3 + 1) * 1024);
    SPAN_E(6);
    SPAN_B(1); xcd_barrier(xb); SPAN_E(1);
    for (int rep = 0; rep < REP_G; rep++) { SPAN_B(4); gemm_phase_k<2>(kparams(), l, 0, lds); SPAN_E(4); SPAN_B(1); xcd_barrier(xb); SPAN_E(1); }
    {
      volatile int* s_item = (volatile int*)(smem + 2 * HALF_SMEM);
      const int half = otid() >> 8;
      char* hs = smem + half * HALF_SMEM;
      SPAN_B(7);
      {
        unsigned* cnt = (unsigned*)(kparams().ws + OFF_CNT) + 64 * (2 * l);
        bool first = true;
        for (;;) {
          int q;
          if (first) { q = (int)blockIdx.x; first = false; }
          else {
            __syncthreads();
            if (otid() == 0) *s_item = (int)gridDim.x + (int)atomicAdd(cnt, 1u);
            __syncthreads();
            q = *s_item;
          }
          if (q >= 864) break;
          if (q < 32) { for (int rep = 0; rep < REP_FL; rep++) fourier_unit(kparams(), q, lds); }
          else if (q < 416 || q >= 672) { const int it = q < 416 ? (q - 32) * 2 + half : 768 + (q - 672) * 2 + half; for (int rep = 0; rep < REP_AL; rep++) attn_tile(kparams(), l, it, hs); }
          else { for (int rep = 0; rep < REP_SS; rep++) ssd_state_tile(kparams(), l, (q - 416) * 2 + half, hs); }
        }
      }
      SPAN_B(1); xcd_barrier(xb); SPAN_E(1);
      SPAN_E(7);
      SPAN_B(8); ssd_prefix(kparams(), l); SPAN_E(8);
      SPAN_B(9);
      SPAN_B(1); xcd_barrier(xb); SPAN_E(1);
      {
        unsigned* cnt = (unsigned*)(kparams().ws + OFF_CNT) + 64 * (2 * l + 1);
        bool first = true;
        for (;;) {
          int q;
          if (first) { q = (int)blockIdx.x; first = false; }
          else {
            __syncthreads();
            if (otid() == 0) *s_item = (int)gridDim.x + (int)atomicAdd(cnt, 1u);
            __syncthreads();
            q = *s_item;
          }
          if (q >= 480) break;
          if (q < 256) { for (int rep = 0; rep < REP_SO; rep++) ssd_out_tile(kparams(), l, q * 2 + half, hs); }
          else if (q < 448) { for (int rep = 0; rep < REP_AC; rep++) attn_tile(kparams(), l, 768 + 384 + (q - 256) * 2 + half, hs); }
          else fourier_unit(kparams(), 32 + (q - 448), lds);
        }
      }
      SPAN_B(1); xcd_barrier(xb); SPAN_E(1);
    }
    SPAN_E(9);
    for (int rep = 0; rep < REP_G; rep++) { SPAN_B(5); gemm_phase_k<3>(kparams(), l, 0, lds); SPAN_E(5); SPAN_B(1); xcd_barrier(xb); SPAN_E(1); }
    SPAN_B(6);
    rowpass(kparams(), true, false, true, l, 5, kparams().norm_post + (l * 3 + 1) * 1024, 1.0f, true, l, 6,
            kparams().norm_pre + (l * 3 + 2) * 1024);
    SPAN_E(6);
    SPAN_B(1); xcd_barrier(xb); SPAN_E(1);
    for (int rep = 0; rep < REP_G; rep++) { SPAN_B(2); gemm_phase_k<0>(kparams(), l, 1, lds); SPAN_E(2); SPAN_B(1); xcd_barrier(xb); SPAN_E(1); }
    for (int rep = 0; rep < REP_G; rep++) { SPAN_B(3); gemm_phase_k<1>(kparams(), l, 1, lds); SPAN_E(3); SPAN_B(1); xcd_barrier(xb); SPAN_E(1); }
    SPAN_B(6);
    rowpass(kparams(), true, l == 1, true, l, 8, kparams().norm_post + (l * 3 + 2) * 1024, 0.5f, l == 0, 1, 0,
            kparams().norm_pre + 3 * 1024);
    SPAN_E(6);
    if (l == 0) { SPAN_B(1); xcd_barrier(xb); SPAN_E(1); }
}

__global__ void __launch_bounds__(512, 2) mega(Params p_unused) {
  extern __shared__ __attribute__((aligned(16))) unsigned char dsm[];
  PG8_LAS unsigned char* lds = (PG8_LAS unsigned char*)dsm;
  char* smem = (char*)dsm;
  cg::grid_group grid = cg::this_grid();
  volatile LAS unsigned* xst = (volatile LAS unsigned*)(dsm + 2 * HALF_SMEM + 16);
  if (otid() == 0) { xst[0] = 0u; xst[1] = 0u; }
  __syncthreads();
  XcdBarrier xb = xcd_barrier_post((unsigned*)(kparams().ws + OFF_BAR), xst);
  unsigned long long span_acc = 0, span_t0 = 0;
  SPAN_B(10);
  for (int rep = 0; rep < REP_P0; rep++) { phase0(kparams(), smem, span_acc); xcd_barrier(xb); }
  if (kparams().ws == nullptr) grid.sync();
  SPAN_E(10);
  rowpass(kparams(), false, false, false, 0, 0, nullptr, 0.f, true, 0, 0, kparams().norm_pre);
  SPAN_B(1); xcd_barrier(xb); SPAN_E(1);
  layer_body<0>(xb, smem, lds, span_acc);
  layer_body<1>(xb, smem, lds, span_acc);
  if (PROBE_SPAN != 0 && blockIdx.x == 0) {
    const unsigned long long t_end = __builtin_amdgcn_s_memrealtime() + 2 * span_acc;
    while (__builtin_amdgcn_s_memrealtime() < t_end) __builtin_amdgcn_s_sleep(8);
  }
}

extern "C" void kernel_launch(void* const* d_in, const int* in_sizes, int n_in, void* d_out, int out_size, void* d_ws,
                              size_t ws_size, hipStream_t stream) {
  static int grid_blocks = 0;
  if (!grid_blocks) {
    int dev = 0, cus = 0, per_cu = 0;
    (void)hipGetDevice(&dev);
    (void)hipDeviceGetAttribute(&cus, hipDeviceAttributeMultiprocessorCount, dev);
    (void)hipFuncSetAttribute((const void*)mega, hipFuncAttributeMaxDynamicSharedMemorySize, DYN_SMEM);
    (void)hipOccupancyMaxActiveBlocksPerMultiprocessor(&per_cu, mega, 512, DYN_SMEM);
    if (per_cu > 1) per_cu = 1;
    if (per_cu < 1) per_cu = 1;
    grid_blocks = cus * per_cu;
  }
  if (ws_size < WS_NEED) fprintf(stderr, "workspace too small: %zu < %zu\n", ws_size, (size_t)WS_NEED);
  Params p{};
  const float** pp = (const float**)&p;
  for (int i = 0; i < 23; i++) pp[i] = (const float*)d_in[i];
  p.out = (float*)d_out;
  p.ws = (char*)d_ws;
  (void)hipMemsetAsync((char*)d_ws + OFF_CNT, 0, 1024 + 16384, stream);
  void* args[] = {&p};
  hipError_t e = hipLaunchCooperativeKernel((void*)mega, dim3(grid_blocks), dim3(512), args, DYN_SMEM, stream);
  if (e != hipSuccess) fprintf(stderr, "cooperative launch failed: %s (grid %d)\n", hipGetErrorString(e), grid_blocks);
}
```
